# Optimizing an MI355X kernel written in HIP

```python
import math
import jax, jax.numpy as jnp
from jax import lax
import numpy as np

D_MODEL = 2048
BATCH = 8
SEQ = 2048
DEPTH = 1

ML_HEADS = 8
ML_QK_DIM = D_MODEL // 2 // ML_HEADS
ML_V_DIM = D_MODEL // ML_HEADS
ML_QK_WIDTH = ML_HEADS * ML_QK_DIM
ML_WIDTH = ML_HEADS * ML_V_DIM
GATE_SOFTCAP = 15.0
DN_HEADS = 16
DN_HEAD_DIM = D_MODEL // DN_HEADS
DN_WIDTH = DN_HEADS * DN_HEAD_DIM
CONV_WIDTH = 4
CHUNK = 64
NORM_EPS = 1e-6

IN_SIZES = (ML_QK_WIDTH, ML_QK_WIDTH, ML_WIDTH, ML_WIDTH, ML_WIDTH, ML_HEADS, ML_HEADS,
            3 * DN_WIDTH, DN_WIDTH, DN_HEADS, DN_HEADS,
            D_MODEL, D_MODEL)
IN_DIM = sum(IN_SIZES)
OUT_DIM = ML_WIDTH + DN_WIDTH

kernel_name = "hybrid_mlstm_gdn_gated_merge"


def _rmsnorm(x, w=None):
    xf = x.astype(jnp.float32)
    y = xf * lax.rsqrt(jnp.mean(xf * xf, axis=-1, keepdims=True) + NORM_EPS)
    return y if w is None else y * w.astype(jnp.float32)


def _l2norm(x):
    return x * lax.rsqrt(jnp.sum(x * x, axis=-1, keepdims=True) + NORM_EPS)


def _heads(t, n):
    b, s, _ = t.shape
    return t.reshape(b, s, n, -1).transpose(0, 2, 1, 3)


def _merge_heads(t):
    b, h, s, d = t.shape
    return t.transpose(0, 2, 1, 3).reshape(b, s, h * d)


def _chunks(t):
    b, h, s = t.shape[:3]
    t = t.reshape(b, h, s // CHUNK, CHUNK, *t.shape[3:])
    return jnp.moveaxis(t, 2, 0)


def _unchunk(t):
    nc, b, h, l, d = t.shape
    return jnp.moveaxis(t, 0, 2).reshape(b, h, nc * l, d)


def _softcap(t):
    return GATE_SOFTCAP * jnp.tanh(t / GATE_SOFTCAP)


def _mlstm_chunkwise(q, k, v, i_pre, logf):
    b_, h_, s_, dk = q.shape
    dv = v.shape[-1]
    q = q * (dk ** -0.5)
    qc, kc, vc = _chunks(q), _chunks(k), _chunks(v)
    ic, fc = _chunks(i_pre), _chunks(logf)
    bcum = jnp.cumsum(fc, axis=-1)
    causal = jnp.tril(jnp.ones((CHUNK, CHUNK), dtype=bool))
    dmat = bcum[..., :, None] - bcum[..., None, :] + ic[..., None, :]
    dmat = jnp.where(causal, dmat, -jnp.inf)
    dmax = jnp.max(dmat, axis=-1)
    scores = jnp.einsum('cbhtd,cbhsd->cbhts', qc, kc)
    w_end = bcum[..., -1:] - bcum + ic
    w_end_max = jnp.max(w_end, axis=-1)

    def step(carry, inp):
        C, n, m = carry
        q_c, k_c, v_c, b_c, dm_c, dmax_c, sc_c, we_c, wem_c = inp
        inter_log = b_c + m[..., None]
        m_t = jnp.maximum(inter_log, dmax_c)
        inter_w = jnp.exp(inter_log - m_t)
        intra_w = jnp.exp(dm_c - m_t[..., None]) * sc_c
        num = (inter_w[..., None] * jnp.einsum('bhtd,bhde->bhte', q_c, C)
               + jnp.einsum('bhts,bhse->bhte', intra_w, v_c))
        den = inter_w * jnp.einsum('bhtd,bhd->bht', q_c, n) + jnp.sum(intra_w, axis=-1)
        h = num / jnp.maximum(jnp.abs(den), jnp.exp(-m_t))[..., None]
        m_new = jnp.maximum(b_c[..., -1] + m, wem_c)
        decay = jnp.exp(b_c[..., -1] + m - m_new)
        kw = k_c * jnp.exp(we_c - m_new[..., None])[..., None]
        C_new = decay[..., None, None] * C + jnp.einsum('bhsd,bhse->bhde', kw, v_c)
        n_new = decay[..., None] * n + jnp.sum(kw, axis=-2)
        return (C_new, n_new, m_new), h

    init = (jnp.zeros((b_, h_, dk, dv), jnp.float32),
            jnp.zeros((b_, h_, dk), jnp.float32),
            jnp.zeros((b_, h_), jnp.float32))
    _, hs = lax.scan(step, init, (qc, kc, vc, bcum, dmat, dmax, scores, w_end, w_end_max))
    return _unchunk(hs)


def _gated_delta_chunkwise(q, k, v, beta, g):
    b_, h_, s_, dk = q.shape
    dv = v.shape[-1]
    q = q * (dk ** -0.5)
    qc, kc, vc = _chunks(q), _chunks(k), _chunks(v)
    bc, gc = _chunks(beta), _chunks(g)
    gam = jnp.cumsum(gc, axis=-1)
    incl = jnp.tril(jnp.ones((CHUNK, CHUNK), dtype=bool))
    strict = jnp.tril(jnp.ones((CHUNK, CHUNK), dtype=bool), k=-1)
    rel = gam[..., :, None] - gam[..., None, :]
    decay_mat = jnp.where(incl, jnp.exp(jnp.where(incl, rel, 0.0)), 0.0)
    kk = jnp.einsum('cbhtd,cbhsd->cbhts', kc, kc)
    a_mat = jnp.where(strict, bc[..., :, None] * kk * decay_mat, 0.0)
    lhs = a_mat + jnp.eye(CHUNK, dtype=a_mat.dtype)
    rhs = jnp.concatenate([vc * bc[..., None], kc * (bc * jnp.exp(gam))[..., None]], axis=-1)
    sol = lax.linalg.triangular_solve(lhs, rhs, left_side=True, lower=True, unit_diagonal=True)
    w_val, w_k = sol[..., :dv], sol[..., dv:]
    qk = jnp.einsum('cbhtd,cbhsd->cbhts', qc, kc) * decay_mat
    q_dec = qc * jnp.exp(gam)[..., None]
    k_end = kc * jnp.exp(gam[..., -1:] - gam)[..., None]
    g_end = jnp.exp(gam[..., -1])

    def step(S, inp):
        wv, wk, qk_c, qd, ke, ge = inp
        u = wv - jnp.einsum('bhtd,bhde->bhte', wk, S)
        o = jnp.einsum('bhtd,bhde->bhte', qd, S) + jnp.einsum('bhts,bhse->bhte', qk_c, u)
        S_new = ge[..., None, None] * S + jnp.einsum('bhsd,bhse->bhde', ke, u)
        return S_new, o

    S0 = jnp.zeros((b_, h_, dk, dv), jnp.float32)
    _, os_ = lax.scan(step, S0, (w_val, w_k, qk, q_dec, k_end, g_end))
    return _unchunk(os_)


def _causal_conv_silu(x, w):
    kw = w.shape[0]
    s = x.shape[1]
    xp = jnp.pad(x, ((0, 0), (kw - 1, 0), (0, 0)))
    y = sum(w[j].astype(jnp.float32) * xp[:, j:j + s] for j in range(kw))
    return jax.nn.silu(y)


def _hybrid_layer(h, norm_w, w_in, ml_i_bias, ml_f_bias, ml_norm_w,
                  dn_conv_w, dn_a_log, dn_dt_bias, dn_norm_w, w_out):
    u = _rmsnorm(h, norm_w)
    proj = jnp.matmul(u, w_in.astype(jnp.float32))
    idx = np.cumsum(IN_SIZES)[:-1].tolist()
    (ml_q, ml_k, ml_v, ml_o, ml_z, ml_i, ml_f,
     dn_qkv, dn_z, dn_b, dn_a, gate_a, gate_b) = jnp.split(proj, idx, axis=-1)

    i_pre = _softcap(ml_i + ml_i_bias).transpose(0, 2, 1)
    logf = jax.nn.log_sigmoid(_softcap(ml_f + ml_f_bias)).transpose(0, 2, 1)
    h_a = _mlstm_chunkwise(_heads(ml_q, ML_HEADS), _heads(ml_k, ML_HEADS),
                           _heads(ml_v, ML_HEADS), i_pre, logf)
    h_a = _merge_heads(_rmsnorm(h_a)) * ml_norm_w.astype(jnp.float32)
    h_a = h_a * jax.nn.sigmoid(ml_o) * jax.nn.silu(ml_z)

    qkv = _causal_conv_silu(dn_qkv, dn_conv_w)
    dq, dk_, dv_ = jnp.split(qkv, 3, axis=-1)
    dq = _l2norm(_heads(dq, DN_HEADS))
    dk_ = _l2norm(_heads(dk_, DN_HEADS))
    dv_ = _heads(dv_, DN_HEADS)
    beta = jax.nn.sigmoid(dn_b).transpose(0, 2, 1)
    g = (-jnp.exp(dn_a_log.astype(jnp.float32))
         * jax.nn.softplus(dn_a + dn_dt_bias)).transpose(0, 2, 1)
    h_b = _gated_delta_chunkwise(dq, dk_, dv_, beta, g)
    h_b = _rmsnorm(h_b, dn_norm_w)
    h_b = _merge_heads(h_b) * jax.nn.silu(dn_z)

    w_out = w_out.astype(jnp.float32)
    y_a = jnp.matmul(h_a, w_out[:ML_WIDTH])
    y_b = jnp.matmul(h_b, w_out[ML_WIDTH:])
    return jax.nn.sigmoid(gate_a) * y_a + jax.nn.sigmoid(gate_b) * y_b


def setup_inputs(seed: int = 0) -> dict:
    key = jax.random.key(seed)
    ks = jax.random.split(key, 13)
    x = jax.random.normal(ks[0], (BATCH, SEQ, D_MODEL), jnp.float32)
    norm_w = 1.0 + 0.05 * jax.random.normal(ks[1], (DEPTH, D_MODEL), jnp.float32)
    w_in = jax.random.normal(ks[2], (DEPTH, D_MODEL, IN_DIM), jnp.float32) * D_MODEL ** -0.5
    ml_i_bias = 0.1 * jax.random.normal(ks[3], (DEPTH, ML_HEADS), jnp.float32)
    ml_f_bias = 3.0 + 0.5 * jax.random.normal(ks[4], (DEPTH, ML_HEADS), jnp.float32)
    ml_norm_w = 1.0 + 0.05 * jax.random.normal(ks[5], (DEPTH, ML_WIDTH), jnp.float32)
    dn_conv_w = jax.random.normal(ks[6], (DEPTH, CONV_WIDTH, 3 * DN_WIDTH), jnp.float32) * CONV_WIDTH ** -0.5
    dn_a_log = jnp.log(jax.random.uniform(ks[7], (DEPTH, DN_HEADS), jnp.float32, 1.0, 16.0))
    dt = jnp.exp(jax.random.uniform(ks[8], (DEPTH, DN_HEADS), jnp.float32,
                                    math.log(1e-3), math.log(1e-1)))
    dn_dt_bias = dt + jnp.log(-jnp.expm1(-dt))
    dn_norm_w = 1.0 + 0.05 * jax.random.normal(ks[9], (DEPTH, DN_HEAD_DIM), jnp.float32)
    w_out = jax.random.normal(ks[10], (DEPTH, OUT_DIM, D_MODEL), jnp.float32) * OUT_DIM ** -0.5
    final_norm_w = 1.0 + 0.05 * jax.random.normal(ks[11], (D_MODEL,), jnp.float32)
    return {"x": x, "norm_w": norm_w, "w_in": w_in, "ml_i_bias": ml_i_bias,
            "ml_f_bias": ml_f_bias, "ml_norm_w": ml_norm_w, "dn_conv_w": dn_conv_w,
            "dn_a_log": dn_a_log, "dn_dt_bias": dn_dt_bias, "dn_norm_w": dn_norm_w,
            "w_out": w_out, "final_norm_w": final_norm_w}


def reference(x, norm_w, w_in, ml_i_bias, ml_f_bias, ml_norm_w, dn_conv_w,
              dn_a_log, dn_dt_bias, dn_norm_w, w_out, final_norm_w):
    h = x
    for l in range(DEPTH):
        y = _hybrid_layer(h, norm_w[l], w_in[l], ml_i_bias[l], ml_f_bias[l], ml_norm_w[l],
                          dn_conv_w[l], dn_a_log[l], dn_dt_bias[l], dn_norm_w[l], w_out[l])
        h = h + y.astype(h.dtype)
    return _rmsnorm(h, final_norm_w).astype(x.dtype)
```

```cpp
#include <hip/hip_runtime.h>
#include <hip/hip_cooperative_groups.h>
#include <cstdio>
namespace cg = cooperative_groups;
namespace pg8 {
#define PG8_LAS __attribute__((address_space(3)))
typedef unsigned short bf16_t;
typedef short bf16x8 __attribute__((ext_vector_type(8)));
typedef float f32x4 __attribute__((ext_vector_type(4)));
typedef unsigned u32x4 __attribute__((ext_vector_type(4)));
constexpr int BM = 256, BK = 64, HALF = 128, HTB = HALF * BK * 2  , STAGE_BYTES = 8 * HTB, NXCD = 8, WGM = 8;

__host__ __device__ __forceinline__ int lds_byte(int r, int c) { const int st = (r >> 4) * 2 + (c >> 5), rr = r & 15, cc = c & 31, ob = rr * 64 + cc * 2; return st * 1024 + (ob ^ (((ob >> 9) & 1) << 5)); }
__host__ __device__ __forceinline__ void stage_rc(int b, int& R, int& C) { const int st = b / 1024, sb = b % 1024, swz = sb ^ (((sb >> 9) & 1) << 5); R = (st >> 1) * 16 + swz / 64; C = (st & 1) * 32 + (swz % 64) / 2; }
__host__ __device__ __forceinline__ int perm32(int rho) { const int n = rho >> 4, i = rho & 15; return 8 * (i >> 2) + 4 * n + (i & 3); }

struct Unit { int pm, pn; };
struct Gemm { const bf16_t* A; const bf16_t* Bt; int M, N, K; };

struct StaticOrder {
    int nM, nN, nwg, G, c;
    __host__ __device__ void init(int M, int N, int G_, int c_) { nM = M / BM; nN = N / BM; nwg = nM * nN; G = G_; c = c_; }
    __host__ __device__ bool next(int i, Unit& u) const {
        const long L = (long)i * G + c; if (L >= nwg) return false;
        int wgid = (int)L; { const int q = nwg / NXCD, r = nwg % NXCD, xcd = wgid % NXCD, off = wgid / NXCD; wgid = (xcd < r ? xcd * (q + 1) : r * (q + 1) + (xcd - r) * q) + off; }
        const int nig = WGM * nN, gid = wgid / nig, fm = gid * WGM, gsz = (nM - fm) < WGM ? (nM - fm) : WGM;
        u.pm = fm + ((wgid % nig) % gsz); u.pn = (wgid % nig) / gsz; return true;
    }
    __device__ __forceinline__ void a_ready(const Unit&) const {}
    __device__ __forceinline__ void done(const Unit&) const {}
};
__device__ __forceinline__ unsigned cvt_pk_bf16(float lo, float hi) { unsigned r; asm volatile("v_cvt_pk_bf16_f32 %0, %1, %2" : "=v"(r) : "v"(lo), "v"(hi)); return r; }
template <class Epi, class Sched, bool STAMP = false>
__device__ __forceinline__ void gemm_phase(PG8_LAS unsigned char* lds, const Gemm g, const Sched& S, const Epi& E, unsigned long long* stamps) {
    const int tid = threadIdx.x, wid = __builtin_amdgcn_readfirstlane(tid >> 6), lane = tid & 63, wr = wid >> 2, wc = wid & 3, fr = lane & 15, fq = lane >> 4;
    const int K = g.K, nt = K / BK;
    int ts_lo = 0, ts_hi = 0, nts = 0; const unsigned long long rt_entry = STAMP ? (unsigned long long)wall_clock64() : 0ull;
#define PG8_STAMP() do { if (STAMP && wid == 0 && nts < 64) { const unsigned long long _c = (unsigned long long)clock64(); \
        ts_lo = (lane == nts) ? (int)(unsigned)_c : ts_lo; ts_hi = (lane == nts) ? (int)(unsigned)(_c >> 32) : ts_hi; ++nts; } } while (0)
    PG8_STAMP();
    unsigned voffA[2], voffB[2];
#pragma unroll
    for (int i = 0; i < 2; ++i) { int R, C; stage_rc(tid * 16 + i * 8192, R, C); const int Rb = Epi::PERM ? ((R & ~31) + perm32(R & 31)) : R;
        voffA[i] = (unsigned)(R * K + C) * 2u; voffB[i] = (unsigned)(Rb * K + C) * 2u; }
    const size_t kstep = (size_t)(BK * 2);
    const size_t hstep = (size_t)HALF * K * 2;
    const size_t tstep = 2 * hstep;
    const unsigned ldsw = (unsigned)wid * 1024u;
    const int aoff = lds_byte(wr * 64 + fr, fq * 8), boff = lds_byte(wc * 32 + fr, fq * 8);
#define PG8_SA(b, h) (((b) * 2 + (h)) * HTB)
#define PG8_SB(b, h) ((4 + (b) * 2 + (h)) * HTB)
#define PG8_STAGE(bufoff, gbase, voff) do { _Pragma("unroll") for (int _i = 0; _i < 2; ++_i) \
        __builtin_amdgcn_global_load_lds((const unsigned*)((const char*)(gbase) + (voff)[_i]), (PG8_LAS unsigned*)(lds + (bufoff) + ldsw + _i * 8192), 16, 0, 0); } while (0)
#define PG8_LDA(dst, b, h) do { _Pragma("unroll") for (int m = 0; m < 4; ++m) _Pragma("unroll") for (int k = 0; k < 2; ++k) dst[m][k] = *(const PG8_LAS bf16x8*)(lds + PG8_SA(b, h) + aoff + m * 2048 + k * 1024); } while (0)
#define PG8_LDB(dst, b, h) do { _Pragma("unroll") for (int n = 0; n < 2; ++n) _Pragma("unroll") for (int k = 0; k < 2; ++k) dst[n][k] = *(const PG8_LAS bf16x8*)(lds + PG8_SB(b, h) + boff + n * 2048 + k * 1024); } while (0)
#define PG8_MMA(ai, bj, At, Bt) do { __builtin_amdgcn_s_setprio(1); _Pragma("unroll") for (int m = 0; m < 4; ++m) _Pragma("unroll") for (int n = 0; n < 2; ++n) _Pragma("unroll") for (int k = 0; k < 2; ++k) \
        acc[ai][bj][m][n] = __builtin_amdgcn_mfma_f32_16x16x32_bf16(Bt[n][k], At[m][k], acc[ai][bj][m][n], 0, 0, 0); __builtin_amdgcn_s_setprio(0); } while (0)
#define PG8_WAIT_V(n) asm volatile("s_waitcnt vmcnt(" #n ")" ::: "memory")
#define PG8_WAIT_L(n) asm volatile("s_waitcnt lgkmcnt(" #n ")" ::: "memory")
#define PG8_BAR __builtin_amdgcn_s_barrier()
#define PG8_SCHED __builtin_amdgcn_sched_barrier(0)
    Unit cur, nxt; int ui = 0;
    if (!S.next(0, cur)) return;
    f32x4 acc[2][2][4][2];
#pragma unroll
    for (int a = 0; a < 2; ++a)
#pragma unroll
        for (int b = 0; b < 2; ++b)
#pragma unroll
            for (int m = 0; m < 4; ++m)
#pragma unroll
                for (int n = 0; n < 2; ++n) acc[a][b][m][n] = (f32x4){0.f, 0.f, 0.f, 0.f};
    bf16x8 At[4][2], B0[2][2], B1[2][2];
    const char* cA = (const char*)g.A + (size_t)cur.pm * tstep; const char* cB = (const char*)g.Bt + (size_t)cur.pn * tstep;
    S.a_ready(cur);
    PG8_STAGE(PG8_SB(0, 0), cB, voffB); PG8_STAGE(PG8_SA(0, 0), cA, voffA); PG8_STAGE(PG8_SB(0, 1), cB + hstep, voffB); PG8_STAGE(PG8_SA(0, 1), cA + hstep, voffA);
    if (wr == 1) PG8_BAR;
    PG8_WAIT_V(4); PG8_BAR;
    PG8_STAGE(PG8_SB(1, 0), cB + kstep, voffB); PG8_STAGE(PG8_SA(1, 0), cA + kstep, voffA); PG8_STAGE(PG8_SB(1, 1), cB + hstep + kstep, voffB);
    PG8_WAIT_V(6); PG8_BAR;
    PG8_STAMP();
    for (;;) {
        const bool has_next = S.next(ui + 1, nxt);
        const char* nA = has_next ? (const char*)g.A + (size_t)nxt.pm * tstep : cA; const char* nB = has_next ? (const char*)g.Bt + (size_t)nxt.pn * tstep : cB;
        for (int t = 0; t < nt; t += 2) {
            const bool last = (t == nt - 2);
            const char* a1 = cA + (size_t)(t + 1) * kstep;
            const char* a2 = last ? nA : cA + (size_t)(t + 2) * kstep; const char* b2 = last ? nB : cB + (size_t)(t + 2) * kstep;
            const char* a3 = a2 + kstep; const char* b3 = b2 + kstep;
            if (last && has_next) S.a_ready(nxt);
            PG8_LDB(B0, 0, 0); PG8_SCHED; PG8_LDA(At, 0, 0); PG8_STAGE(PG8_SA(1, 1), a1 + hstep, voffA);
            PG8_WAIT_L(8); PG8_BAR; PG8_WAIT_L(0); PG8_MMA(0, 0, At, B0); PG8_BAR; PG8_SCHED;
            PG8_LDB(B1, 0, 1); PG8_STAGE(PG8_SB(0, 0), b2, voffB);
            PG8_BAR; PG8_WAIT_L(0); PG8_MMA(0, 1, At, B1); PG8_BAR;
            PG8_LDA(At, 0, 1); PG8_STAGE(PG8_SA(0, 0), a2, voffA);
            PG8_BAR; PG8_WAIT_L(0); PG8_MMA(1, 0, At, B0); PG8_BAR; PG8_SCHED;
            PG8_STAGE(PG8_SB(0, 1), b2 + hstep, voffB);
            PG8_WAIT_V(6); PG8_BAR; PG8_MMA(1, 1, At, B1); PG8_BAR;
            PG8_LDB(B0, 1, 0); PG8_SCHED; PG8_LDA(At, 1, 0); PG8_STAGE(PG8_SA(0, 1), a2 + hstep, voffA);
            PG8_WAIT_L(8); PG8_BAR; PG8_WAIT_L(0); PG8_MMA(0, 0, At, B0); PG8_BAR; PG8_SCHED;
            PG8_LDB(B1, 1, 1); PG8_STAGE(PG8_SB(1, 0), b3, voffB);
            PG8_BAR; PG8_WAIT_L(0); PG8_MMA(0, 1, At, B1); PG8_BAR;
            PG8_LDA(At, 1, 1); PG8_STAGE(PG8_SA(1, 0), a3, voffA);
            PG8_BAR; PG8_WAIT_L(0); PG8_MMA(1, 0, At, B0); PG8_BAR; PG8_SCHED;
            PG8_STAGE(PG8_SB(1, 1), b3 + hstep, voffB);
            PG8_WAIT_V(6); PG8_BAR; PG8_MMA(1, 1, At, B1); PG8_BAR;
        }
        PG8_STAMP();
        if constexpr (!Epi::AFTER_DRAIN) { E(acc, cur, wr, wc, fr, fq); S.done(cur); }
        PG8_STAMP();
        if (!has_next) break;
#pragma unroll
        for (int a = 0; a < 2; ++a)
#pragma unroll
            for (int b = 0; b < 2; ++b)
#pragma unroll
                for (int m = 0; m < 4; ++m)
#pragma unroll
                    for (int n = 0; n < 2; ++n) acc[a][b][m][n] = (f32x4){0.f, 0.f, 0.f, 0.f};
        cur = nxt; cA = nA; cB = nB; ++ui;
    }
    PG8_WAIT_V(0);
    if (wr == 0) PG8_BAR;
    PG8_BAR;
    if constexpr (Epi::AFTER_DRAIN) { E.fused(acc, cur, wr, wc, fr, fq, lds, wid, lane); S.done(cur); }
    PG8_STAMP();
    if (STAMP && wid == 0) { stamps[lane] = lane < nts ? (((unsigned long long)(unsigned)ts_hi << 32) | (unsigned)ts_lo) : 0ull;
        if (lane == 62) stamps[62] = rt_entry; if (lane == 63) stamps[63] = (unsigned long long)wall_clock64(); }
#undef PG8_STAMP
#undef PG8_SA
#undef PG8_SB
#undef PG8_STAGE
#undef PG8_LDA
#undef PG8_LDB
#undef PG8_MMA
#undef PG8_WAIT_V
#undef PG8_WAIT_L
#undef PG8_BAR
#undef PG8_SCHED
}
}

#define DI __device__ __forceinline__
typedef unsigned short bf16_t;
typedef short bf16x8 __attribute__((ext_vector_type(8)));
typedef float f32x4 __attribute__((ext_vector_type(4)));
typedef unsigned u32x4 __attribute__((ext_vector_type(4)));
typedef unsigned u32x2 __attribute__((ext_vector_type(2)));

constexpr int T_TOK = 16384, DM = 2048, IN_DIM = 20528, NPAD = 20736;
constexpr int LDS_BYTES = 140 * 1024;
constexpr float EPS = 1e-6f;

constexpr size_t SZ_T2048 = (size_t)T_TOK * 2048 * 2;
constexpr size_t OFF_WT = 0;
constexpr size_t OFF_QK = 0;
constexpr size_t OFF_U = OFF_WT + (size_t)NPAD * 2048 * 2;
constexpr size_t OFF_WK = OFF_U;
constexpr size_t OFF_MLV = OFF_U + SZ_T2048;
constexpr size_t OFF_MLQ = OFF_MLV + SZ_T2048;
constexpr size_t OFF_MLK = OFF_MLQ + SZ_T2048 / 2;
constexpr size_t OFF_OZ = OFF_MLK + SZ_T2048 / 2;
constexpr size_t OFF_DNQKV = OFF_OZ + SZ_T2048;
constexpr size_t OFF_PBUF = OFF_DNQKV;
constexpr size_t OFF_SDZ = OFF_DNQKV + 3 * SZ_T2048;
constexpr size_t OFF_GATES = OFF_SDZ + SZ_T2048;
constexpr size_t OFF_HALO = OFF_GATES + (size_t)T_TOK * 64 * 4;
constexpr size_t OFF_WOT = OFF_HALO + (size_t)256 * 3 * 6144 * 2;
constexpr size_t OFF_ROWSS = OFF_WOT + (size_t)2 * 2048 * 2048 * 2;
constexpr size_t OFF_GE = OFF_ROWSS + (size_t)T_TOK * 4;
constexpr size_t WS_END = OFF_GE + 4096 * 4;

struct Params {
    const float *x, *norm_w, *w_in, *ml_i_bias, *ml_f_bias, *ml_norm_w, *dn_conv_w, *dn_a_log, *dn_dt_bias, *dn_norm_w, *w_out, *final_norm_w;
    float* out; unsigned char* ws; int ph_lo, ph_hi;
};

typedef __bf16 bf16x2_t __attribute__((ext_vector_type(2)));
typedef float f32x2_t __attribute__((ext_vector_type(2)));
DI unsigned pk(float lo, float hi) { const f32x2_t v = {lo, hi}; const bf16x2_t b = __builtin_convertvector(v, bf16x2_t); return __builtin_bit_cast(unsigned, b); }
DI bf16_t f2bf(float f) { return (bf16_t)(pk(f, 0.f) & 0xffffu); }
DI float bf2f(bf16_t b) { return __uint_as_float(((unsigned)b) << 16); }
DI float bflo(unsigned u) { return __uint_as_float(u << 16); }
DI float bfhi(unsigned u) { return __uint_as_float(u & 0xffff0000u); }
DI float sigmoidf_(float x) { return __fdividef(1.f, 1.f + __expf(-x)); }
DI float softplusf_(float x) { return fmaxf(x, 0.f) + log1pf(__expf(-fabsf(x))); }
DI float softcapf_(float x) { return 15.f * tanhf(x * (1.f / 15.f)); }
DI float wave_sum(float v) { for (int d = 32; d >= 1; d >>= 1) v += __shfl_xor(v, d); return v; }
DI float wave_incl_sum(float v, int lane) { for (int d = 1; d < 64; d <<= 1) { float o = __shfl_up(v, d); if (lane >= d) v += o; } return v; }
DI float wave_incl_max(float v, int lane) { for (int d = 1; d < 64; d <<= 1) { float o = __shfl_up(v, d); if (lane >= d) v = fmaxf(v, o); } return v; }
DI void unpack8(const u32x4& r, float (&f)[8]) {
#pragma unroll
    for (int e = 0; e < 4; ++e) { f[2 * e] = bflo(r[e]); f[2 * e + 1] = bfhi(r[e]); }
}
DI u32x4 pack8(const float (&f)[8]) { u32x4 r; r.x = pk(f[0], f[1]); r.y = pk(f[2], f[3]); r.z = pk(f[4], f[5]); r.w = pk(f[6], f[7]); return r; }

template <int KS> DI void mma16(f32x4& acc, const bf16_t* A, int lda, int arow0, const bf16_t* Bt, int ldb, int brow0, int lane) {
    const int r = lane & 15, q = lane >> 4;
    const bf16_t* ap = A + (arow0 + r) * lda + q * 8;
    const bf16_t* bp = Bt + (brow0 + r) * ldb + q * 8;
#pragma unroll
    for (int ks = 0; ks < KS; ++ks) {
        const bf16x8 a = *(const bf16x8*)(ap + ks * 32), b = *(const bf16x8*)(bp + ks * 32);
        acc = __builtin_amdgcn_mfma_f32_16x16x32_bf16(a, b, acc, 0, 0, 0);
    }
}

DI int src_col(int np) {
    if (np < 4096) return np;
    if (np < 8192) { const int j = (np - 4096) >> 8, r = (np - 4096) & 255; return r < 128 ? 4096 + 128 * j + r : 6144 + 128 * j + (r - 128); }
    if (np < 14336) return 8208 + (np - 8192);
    if (np < 16384) return 14352 + (np - 14336);
    if (np < 20480) { const int j = (np - 16384) >> 8, r = (np - 16384) & 255; return r < 128 ? 16432 + 128 * j + r : 18480 + 128 * j + (r - 128); }
    if (np < 20496) return 8192 + (np - 20480);
    if (np < 20528) return 16400 + (np - 20496);
    return -1;
}

DI void p0_prologue(const Params& p, unsigned char* lds) {
    const int tid = threadIdx.x, lane = tid & 63, wid = tid >> 6;
    float* rowss = (float*)(p.ws + OFF_ROWSS);
    for (int i = blockIdx.x * 512 + tid; i < T_TOK; i += gridDim.x * 512) rowss[i] = 0.f;
    bf16_t* U = (bf16_t*)(p.ws + OFF_U);
    for (int row = blockIdx.x * 8 + wid; row < T_TOK; row += gridDim.x * 8) {
        const float4* xr = (const float4*)(p.x + (size_t)row * DM);
        float4 v[8]; float ss = 0.f;
#pragma unroll
        for (int i = 0; i < 8; ++i) { v[i] = xr[i * 64 + lane]; ss += v[i].x * v[i].x + v[i].y * v[i].y + v[i].z * v[i].z + v[i].w * v[i].w; }
        ss = wave_sum(ss);
        const float rs = rsqrtf(ss * (1.f / 2048.f) + EPS);
#pragma unroll
        for (int i = 0; i < 8; ++i) { const float4 w = ((const float4*)p.norm_w)[i * 64 + lane];
            u32x2 o; o.x = pk(v[i].x * rs * w.x, v[i].y * rs * w.y); o.y = pk(v[i].z * rs * w.z, v[i].w * rs * w.w);
            *(u32x2*)(U + (size_t)row * DM + (i * 64 + lane) * 4) = o; }
    }
    float* tile = (float*)lds;
    constexpr int NT_IN = (NPAD / 64) * 32, NT_OUT = 2 * 32 * 32;
    bf16_t* Wt = (bf16_t*)(p.ws + OFF_WT); bf16_t* WoT = (bf16_t*)(p.ws + OFF_WOT);
    for (int tix = blockIdx.x; tix < NT_IN + NT_OUT; tix += gridDim.x) {
        const float* src; size_t ld; int sc, k0; bf16_t* dst;
        if (tix < NT_IN) { const int ntile = tix >> 5, kt = tix & 31; k0 = kt * 64; sc = src_col(ntile * 64 + lane); src = p.w_in; ld = IN_DIM; dst = Wt + (size_t)ntile * 64 * 2048; }
        else { const int r = tix - NT_IN, half = r >> 10, r2 = r & 1023, ntile = r2 >> 5, kt = r2 & 31; k0 = kt * 64; sc = ntile * 64 + lane; src = p.w_out + (size_t)half * 2048 * 2048; ld = 2048; dst = WoT + (size_t)half * 2048 * 2048 + (size_t)ntile * 64 * 2048; }
#pragma unroll
        for (int i = 0; i < 8; ++i) { const int kk = i * 8 + wid; tile[kk * 65 + lane] = sc >= 0 ? src[(size_t)(k0 + kk) * ld + sc] : 0.f; }
        __syncthreads();
        { const int nn = tid >> 3, k8 = tid & 7; float f[8];
#pragma unroll
            for (int i = 0; i < 8; ++i) f[i] = tile[(k8 * 8 + i) * 65 + nn];
            *(u32x4*)(dst + (size_t)nn * 2048 + k0 + k8 * 8) = pack8(f); }
        __syncthreads();
    }
}

struct EpiProj {
    static constexpr bool PERM = true, AFTER_DRAIN = false;
    unsigned char* ws; unsigned* dout;
    DI void operator()(const f32x4 (&acc)[2][2][4][2], const pg8::Unit& u, int wr, int wc, int fr, int fq) const {
        const int pn = u.pn;
        const int row0 = u.pm * 256 + wr * 64 + fr;
        const int lc = wc * 32 + 8 * fq;
        if (pn < 16 || (pn >= 32 && pn < 56)) {
            bf16_t* base; int ldc, colt; float sc = 1.f; bool halo = false;
            if (pn < 4) { base = (bf16_t*)(ws + OFF_MLQ); ldc = 1024; colt = pn * 256; sc = 0.08838834764831845f; }
            else if (pn < 8) { base = (bf16_t*)(ws + OFF_MLK); ldc = 1024; colt = (pn - 4) * 256; }
            else if (pn < 16) { base = (bf16_t*)(ws + OFF_MLV); ldc = 2048; colt = (pn - 8) * 256; }
            else { base = (bf16_t*)(ws + OFF_DNQKV); ldc = 6144; colt = (pn - 32) * 256; halo = true; }
            bf16_t* hb = (bf16_t*)(ws + OFF_HALO);
#pragma unroll
            for (int ai = 0; ai < 2; ++ai)
#pragma unroll
                for (int m = 0; m < 4; ++m) { const int row = row0 + ai * 128 + m * 16; bf16_t* rowp = base + (size_t)row * ldc + colt + lc;
#pragma unroll
                    for (int bj = 0; bj < 2; ++bj) { const f32x4 v0 = acc[ai][bj][m][0] * sc, v1 = acc[ai][bj][m][1] * sc;
                        u32x4 w; w.x = pk(v0[0], v0[1]); w.y = pk(v0[2], v0[3]); w.z = pk(v1[0], v1[1]); w.w = pk(v1[2], v1[3]);
                        *(u32x4*)(rowp + bj * 128) = w;
                        if (halo && (row & 63) >= 61) *(u32x4*)(hb + ((size_t)(row >> 6) * 3 + ((row & 63) - 61)) * 6144 + colt + lc + bj * 128) = w; } }
        } else if (pn < 32) {
            bf16_t* base = (bf16_t*)(ws + OFF_OZ) + (pn - 16) * 128 + lc;
#pragma unroll
            for (int ai = 0; ai < 2; ++ai)
#pragma unroll
                for (int m = 0; m < 4; ++m) { const int row = row0 + ai * 128 + m * 16; float f[8];
#pragma unroll
                    for (int n = 0; n < 2; ++n)
#pragma unroll
                        for (int i = 0; i < 4; ++i) { const float o = acc[ai][0][m][n][i], z = acc[ai][1][m][n][i]; f[n * 4 + i] = sigmoidf_(o) * z * sigmoidf_(z); }
                    *(u32x4*)(base + (size_t)row * 2048) = pack8(f); }
        } else if (pn < 64) {
            bf16_t* base = (bf16_t*)(ws + OFF_SDZ) + (pn - 56) * 256 + lc;
#pragma unroll
            for (int ai = 0; ai < 2; ++ai)
#pragma unroll
                for (int m = 0; m < 4; ++m) { const int row = row0 + ai * 128 + m * 16;
#pragma unroll
                    for (int bj = 0; bj < 2; ++bj) { float f[8];
#pragma unroll
                        for (int n = 0; n < 2; ++n)
#pragma unroll
                            for (int i = 0; i < 4; ++i) { const float z = acc[ai][bj][m][n][i]; f[n * 4 + i] = z * sigmoidf_(z); }
                        *(u32x4*)(base + (size_t)row * 2048 + bj * 128) = pack8(f); } }
        } else if (pn < 80) {
            unsigned* base = dout + (pn - 64) * 128 + lc;
#pragma unroll
            for (int ai = 0; ai < 2; ++ai)
#pragma unroll
                for (int m = 0; m < 4; ++m) { const int row = row0 + ai * 128 + m * 16;
#pragma unroll
                    for (int n = 0; n < 2; ++n) { u32x4 w;
#pragma unroll
                        for (int i = 0; i < 4; ++i) w[i] = pk(sigmoidf_(acc[ai][0][m][n][i]), sigmoidf_(acc[ai][1][m][n][i]));
                        *(u32x4*)(base + (size_t)row * 2048 + 4 * n) = w; } }
        } else {
            if (wc < 2) { float* base = (float*)(ws + OFF_GATES) + lc;
#pragma unroll
                for (int ai = 0; ai < 2; ++ai)
#pragma unroll
                    for (int m = 0; m < 4; ++m) { const int row = row0 + ai * 128 + m * 16;
#pragma unroll
                        for (int n = 0; n < 2; ++n) *(f32x4*)(base + (size_t)row * 64 + 4 * n) = acc[ai][0][m][n]; } }
        }
    }
};

struct EpiOut {
    static constexpr bool PERM = false, AFTER_DRAIN = false;
    const float* x; float* out; float* pbuf; float* rowss;
    DI void operator()(const f32x4 (&acc)[2][2][4][2], const pg8::Unit& u, int wr, int wc, int fr, int fq) const {
        const bool half = u.pm >= 64; const int pm = u.pm & 63, pn = u.pn & 7;
        const int row0 = pm * 256 + wr * 64 + fr, col0 = pn * 256 + wc * 32 + 4 * fq;
#pragma unroll
        for (int ai = 0; ai < 2; ++ai)
#pragma unroll
            for (int m = 0; m < 4; ++m) { const int row = row0 + ai * 128 + m * 16; const size_t off = (size_t)row * 2048 + col0; float ss = 0.f;
#pragma unroll
                for (int bj = 0; bj < 2; ++bj)
#pragma unroll
                    for (int n = 0; n < 2; ++n) { const size_t o = off + bj * 128 + n * 16; const u32x4 pr = *(const u32x4*)((const unsigned*)out + o);
                        if (!half) { f32x4 g; g[0] = bflo(pr[0]); g[1] = bflo(pr[1]); g[2] = bflo(pr[2]); g[3] = bflo(pr[3]); *(f32x4*)(pbuf + o) = g * acc[ai][bj][m][n]; }
                        else { f32x4 g; g[0] = bfhi(pr[0]); g[1] = bfhi(pr[1]); g[2] = bfhi(pr[2]); g[3] = bfhi(pr[3]);
                            const f32x4 xv = *(const f32x4*)(x + o), pv = *(const f32x4*)(pbuf + o); const f32x4 hh = xv + pv + g * acc[ai][bj][m][n];
                            *(f32x4*)(out + o) = hh; ss += hh[0] * hh[0] + hh[1] * hh[1] + hh[2] * hh[2] + hh[3] * hh[3]; } }
                if (half) { ss += __shfl_xor(ss, 16); ss += __shfl_xor(ss, 32); if (fq == 0) atomicAdd(rowss + row, ss); }
                asm volatile("" ::: "memory"); }
    }
};
struct OutOrder {
    pg8::StaticOrder so;
    DI bool next(int i, pg8::Unit& u) const { pg8::Unit t; if (!so.next(i >> 1, t)) return false; const int half = i & 1; u.pm = t.pm + 64 * half; u.pn = t.pn + 8 * half; return true; }
    DI void a_ready(const pg8::Unit&) const {}
    DI void done(const pg8::Unit&) const {}
};

DI void p2_dnprep(const Params& p, unsigned char* lds) {
    const int tid = threadIdx.x, lane = tid & 63, wid = tid >> 6;
    bf16_t* sraw = (bf16_t*)lds;
    bf16_t* sqn = (bf16_t*)(lds + 52736);
    bf16_t* skn = sqn + 64 * 136;
    bf16_t* svn = skn + 64 * 136;
    float* sA = (float*)(lds + 104960);
    float* sbeta = (float*)(lds + 122368);
    float* sgam = sbeta + 64; float* sbg = sgam + 64;
    bf16_t* DNQKV = (bf16_t*)(p.ws + OFF_DNQKV); const bf16_t* HALO = (const bf16_t*)(p.ws + OFF_HALO);
    const float* GATES = (const float*)(p.ws + OFF_GATES); bf16_t* WK = (bf16_t*)(p.ws + OFF_WK); bf16_t* QK = (bf16_t*)(p.ws + OFF_QK);
    float* GE = (float*)(p.ws + OFF_GE);
    for (int item = blockIdx.x; item < 4096; item += gridDim.x) {
        const int h = item & 15, bc = item >> 4, c = bc & 31, t0 = bc * 64;
        for (int idx = tid; idx < 67 * 48; idx += 512) { const int r = idx / 48, pc = idx - r * 48, seg = pc >> 4, c8 = (pc & 15) * 8, colg = seg * 2048 + h * 128 + c8;
            u32x4 v = {0u, 0u, 0u, 0u};
            if (r >= 3) v = *(const u32x4*)(DNQKV + (size_t)(t0 + r - 3) * 6144 + colg);
            else if (c > 0) v = *(const u32x4*)(HALO + ((size_t)(bc - 1) * 3 + r) * 6144 + colg);
            *(u32x4*)(sraw + r * 392 + seg * 128 + c8) = v; }
        if (wid == 0) { const float gb = GATES[(size_t)(t0 + lane) * 64 + 16 + h], ga = GATES[(size_t)(t0 + lane) * 64 + 32 + h];
            const float beta = sigmoidf_(gb); const float g = -__expf(p.dn_a_log[h]) * softplusf_(ga + p.dn_dt_bias[h]);
            const float gam = wave_incl_sum(g, lane); sbeta[lane] = beta; sgam[lane] = gam; sbg[lane] = beta * __expf(gam);
            if (lane == 63) GE[item] = __expf(gam); }
        __syncthreads();
#pragma unroll 1
        for (int it = 0; it < 6; ++it) { const int idx = it * 512 + tid, cg16 = idx & 15, st = idx >> 4, which = st >> 6, t = st & 63, col = which * 128 + cg16 * 8;
            float y[8];
#pragma unroll
            for (int e = 0; e < 8; ++e) y[e] = 0.f;
#pragma unroll
            for (int j = 0; j < 4; ++j) { const u32x4 rv = *(const u32x4*)(sraw + (t + j) * 392 + col); float xv[8]; unpack8(rv, xv);
                const float4* wp = (const float4*)(p.dn_conv_w + (size_t)j * 6144 + which * 2048 + h * 128 + cg16 * 8); const float4 w0 = wp[0], w1 = wp[1];
                y[0] += w0.x * xv[0]; y[1] += w0.y * xv[1]; y[2] += w0.z * xv[2]; y[3] += w0.w * xv[3]; y[4] += w1.x * xv[4]; y[5] += w1.y * xv[5]; y[6] += w1.z * xv[6]; y[7] += w1.w * xv[7]; }
            float ss = 0.f;
#pragma unroll
            for (int e = 0; e < 8; ++e) { y[e] = y[e] * sigmoidf_(y[e]); ss += y[e] * y[e]; }
            ss += __shfl_xor(ss, 1); ss += __shfl_xor(ss, 2); ss += __shfl_xor(ss, 4); ss += __shfl_xor(ss, 8);
            const float scale = which == 2 ? 1.f : rsqrtf(ss + EPS) * (which == 0 ? 0.08838834764831845f : 1.f);
#pragma unroll
            for (int e = 0; e < 8; ++e) y[e] *= scale;
            bf16_t* dst = (which == 0 ? sqn : (which == 1 ? skn : svn)) + t * 136 + cg16 * 8;
            *(u32x4*)dst = pack8(y); }
        __syncthreads();
        { const int tr = wid >> 1, tcb = (wid & 1) * 2, q = lane >> 4, cl = lane & 15;
#pragma unroll
            for (int ti = 0; ti < 2; ++ti) { const int tc = tcb + ti; f32x4 akk = {0.f, 0.f, 0.f, 0.f}, aqk = {0.f, 0.f, 0.f, 0.f};
                if (tc <= tr) { mma16<4>(akk, skn, 136, tr * 16, skn, 136, tc * 16, lane); mma16<4>(aqk, sqn, 136, tr * 16, skn, 136, tc * 16, lane); }
                f32x4 av;
#pragma unroll
                for (int reg = 0; reg < 4; ++reg) { const int t = tr * 16 + q * 4 + reg, s = tc * 16 + cl; const float dec = (s <= t) ? __expf(sgam[t] - sgam[s]) : 0.f;
                    av[reg] = (s < t) ? sbeta[t] * akk[reg] * dec : 0.f;
                    QK[(size_t)(t0 + t) * 1024 + h * 64 + s] = f2bf(aqk[reg] * dec); }
                *(f32x4*)(sA + (tc * 16 + cl) * 68 + tr * 16 + q * 4) = av; } }
        __syncthreads();
        if (wid < 4) {
            const int col = tid; const bool isv = col < 128; const bf16_t* src = isv ? svn + col : skn + (col - 128); const float* scl = isv ? sbeta : sbg;
            float* sX = (float*)lds;
            bf16_t* dst = isv ? DNQKV + (size_t)t0 * 6144 + 4096 + h * 128 + col : WK + (size_t)t0 * 2048 + h * 128 + (col - 128);
            const size_t ldd = isv ? 6144 : 2048;
#pragma unroll 1
            for (int I = 0; I < 4; ++I) {
                float R[16];
#pragma unroll
                for (int i = 0; i < 16; ++i) R[i] = bf2f(src[(16 * I + i) * 136]) * scl[16 * I + i];
#pragma unroll 2
                for (int s = 0; s < 16 * I; ++s) { const float x = sX[s * 256 + col]; const f32x4* ap = (const f32x4*)(sA + s * 68 + 16 * I);
                    const f32x4 a0 = ap[0], a1 = ap[1], a2 = ap[2], a3 = ap[3];
#pragma unroll
                    for (int i = 0; i < 4; ++i) { R[i] -= a0[i] * x; R[4 + i] -= a1[i] * x; R[8 + i] -= a2[i] * x; R[12 + i] -= a3[i] * x; } }
#pragma unroll
                for (int j = 0; j < 15; ++j) { const float xj = R[j]; const float* ap = sA + (16 * I + j) * 68 + 16 * I;
#pragma unroll
                    for (int i = j + 1; i < 16; ++i) R[i] -= ap[i] * xj; }
#pragma unroll
                for (int i = 0; i < 16; ++i) { if (I < 3) sX[(16 * I + i) * 256 + col] = R[i]; dst[(size_t)(16 * I + i) * ldd] = f2bf(R[i]); }
            }
        } else {
            const int t2 = tid - 256; const float glast = sgam[63];
#pragma unroll 1
            for (int it = 0; it < 8; ++it) { const int idx = it * 256 + t2, which = idx >> 10, rem = idx & 1023, t = rem >> 4, c8 = (rem & 15) * 8;
                const float sc = which == 0 ? __expf(sgam[t]) : __expf(glast - sgam[t]);
                float f[8]; unpack8(*(const u32x4*)((which == 0 ? sqn : skn) + t * 136 + c8), f);
#pragma unroll
                for (int e = 0; e < 8; ++e) f[e] *= sc;
                *(u32x4*)(DNQKV + (size_t)(t0 + t) * 6144 + which * 2048 + h * 128 + c8) = pack8(f); }
        }
        __syncthreads();
    }
}

DI void scan_dn(const Params& p, unsigned char* lds, int item) {
    const int tid = threadIdx.x, lane = tid & 63, wid = tid >> 6, q = lane >> 4, cl = lane & 15;
    const int b = item >> 4, h = item & 15;
    bf16_t* swk = (bf16_t*)lds;
    bf16_t* sqd = swk + 64 * 136;
    bf16_t* swv = sqd + 64 * 136;
    bf16_t* sqk = swv + 64 * 136;
    bf16_t* skeT = sqk + 64 * 72;
    bf16_t* suT = skeT + 128 * 72;
    bf16_t* sSt = suT + 128 * 72;
    bf16_t* DNQKV = (bf16_t*)(p.ws + OFF_DNQKV); const bf16_t* WK = (const bf16_t*)(p.ws + OFF_WK); const bf16_t* QK = (const bf16_t*)(p.ws + OFF_QK);
    const float* GE = (const float*)(p.ws + OFF_GE);
    for (int i = tid; i < 128 * 136 / 2; i += 512) ((unsigned*)sSt)[i] = 0u;
    f32x4 accS[8];
#pragma unroll
    for (int i = 0; i < 8; ++i) accS[i] = (f32x4){0.f, 0.f, 0.f, 0.f};
    u32x4 rwk[2], rqd[2], rke[2], rwv[2], rqk; float ge;
#define DN_LOAD(cc) do { const size_t tb = (size_t)b * 2048 + (size_t)(cc) * 64; \
        _Pragma("unroll") for (int i = 0; i < 2; ++i) { const int piece = tid + 512 * i, t = piece >> 4, c8 = (piece & 15) * 8; const size_t ro = (tb + t) * 6144 + h * 128 + c8; \
            rwk[i] = *(const u32x4*)(WK + (tb + t) * 2048 + h * 128 + c8); rqd[i] = *(const u32x4*)(DNQKV + ro); rke[i] = *(const u32x4*)(DNQKV + ro + 2048); rwv[i] = *(const u32x4*)(DNQKV + ro + 4096); } \
        rqk = *(const u32x4*)(QK + (tb + (tid >> 3)) * 1024 + h * 64 + (tid & 7) * 8); \
        ge = GE[((size_t)(b * 32 + (cc))) * 16 + h]; } while (0)
    DN_LOAD(0);
    __syncthreads();
#pragma unroll 1
    for (int c = 0; c < 32; ++c) {
        const size_t t0 = (size_t)b * 2048 + (size_t)c * 64;
#pragma unroll
        for (int i = 0; i < 2; ++i) { const int piece = tid + 512 * i, t = piece >> 4, c8 = (piece & 15) * 8;
            *(u32x4*)(swk + t * 136 + c8) = rwk[i]; *(u32x4*)(sqd + t * 136 + c8) = rqd[i]; *(u32x4*)(swv + t * 136 + c8) = rwv[i];
#pragma unroll
            for (int e = 0; e < 8; ++e) skeT[(c8 + e) * 72 + t] = (bf16_t)((rke[i][e >> 1] >> ((e & 1) * 16)) & 0xffffu); }
        *(u32x4*)(sqk + (tid >> 3) * 72 + (tid & 7) * 8) = rqk;
        const float gec = ge;
        if (c + 1 < 32) DN_LOAD(c + 1);
        __syncthreads();
        const int tr = wid & 3, hb = (wid >> 2) * 4;
#pragma unroll
        for (int j = 0; j < 4; ++j) { const int nt = hb + j; f32x4 a = {0.f, 0.f, 0.f, 0.f};
            mma16<4>(a, swk, 136, tr * 16, sSt, 136, nt * 16, lane);
            const int dv = nt * 16 + cl, tq = tr * 16 + q * 4;
            const float u0 = bf2f(swv[(tq + 0) * 136 + dv]) - a[0], u1 = bf2f(swv[(tq + 1) * 136 + dv]) - a[1], u2 = bf2f(swv[(tq + 2) * 136 + dv]) - a[2], u3 = bf2f(swv[(tq + 3) * 136 + dv]) - a[3];
            u32x2 w; w.x = pk(u0, u1); w.y = pk(u2, u3); *(u32x2*)(suT + dv * 72 + tq) = w; }
        __syncthreads();
#pragma unroll
        for (int j = 0; j < 4; ++j) { const int nt = hb + j; f32x4 a = {0.f, 0.f, 0.f, 0.f};
            mma16<4>(a, sqd, 136, tr * 16, sSt, 136, nt * 16, lane);
            mma16<2>(a, sqk, 72, tr * 16, suT, 72, nt * 16, lane);
            const int dv = nt * 16 + cl, tq = tr * 16 + q * 4;
#pragma unroll
            for (int reg = 0; reg < 4; ++reg) DNQKV[(t0 + tq + reg) * 6144 + 4096 + h * 128 + dv] = f2bf(a[reg]); }
#pragma unroll
        for (int nt = 0; nt < 8; ++nt) { accS[nt] *= gec; mma16<2>(accS[nt], skeT, 72, wid * 16, suT, 72, nt * 16, lane); if (nt & 1) asm volatile("" ::: "memory"); }
        __syncthreads();
#pragma unroll
        for (int nt = 0; nt < 8; ++nt) { const int dv = nt * 16 + cl, dk0 = wid * 16 + q * 4; u32x2 w; w.x = pk(accS[nt][0], accS[nt][1]); w.y = pk(accS[nt][2], accS[nt][3]); *(u32x2*)(sSt + dv * 136 + dk0) = w; }
    }
#undef DN_LOAD
    __syncthreads();
}

DI void scan_ml(const Params& p, unsigned char* lds, int item) {
    const int tid = threadIdx.x, lane = tid & 63, wid = tid >> 6, q = lane >> 4, cl = lane & 15;
    const int b = item >> 4, h = (item >> 1) & 7, sl = item & 1, vcol = h * 256 + sl * 128;
    bf16_t* sq = (bf16_t*)lds;
    bf16_t* sk = sq + 64 * 136;
    bf16_t* sCt = sk + 64 * 136;
    bf16_t* skwT = sCt + 144 * 136;
    bf16_t* sVt = skwT + 128 * 72;
    bf16_t* sP = sVt + 144 * 72;
    float* sf = (float*)(sP + 64 * 72);
    float *s_bcum = sf, *s_a = sf + 64, *s_mt = sf + 128, *s_iw = sf + 192, *s_emt = sf + 256, *s_ew = sf + 320, *s_sc = sf + 384;
    const bf16_t* MLQ = (const bf16_t*)(p.ws + OFF_MLQ); const bf16_t* MLK = (const bf16_t*)(p.ws + OFF_MLK); bf16_t* MLV = (bf16_t*)(p.ws + OFF_MLV);
    const float* GATES = (const float*)(p.ws + OFF_GATES);
    for (int i = tid; i < 144 * 136 / 2; i += 512) ((unsigned*)sCt)[i] = 0u;
    for (int i = tid; i < 16 * 72; i += 512) sVt[128 * 72 + i] = (i < 72) ? (bf16_t)0x3F80u : (bf16_t)0u;
    f32x4 accC[9];
#pragma unroll
    for (int i = 0; i < 9; ++i) accC[i] = (f32x4){0.f, 0.f, 0.f, 0.f};
    const float ibias = p.ml_i_bias[h], fbias = p.ml_f_bias[h];
    float m_run = 0.f;
    u32x4 rq[2], rk[2], rv[2]; float gi = 0.f, gf = 0.f;
#define ML_LOAD(cc) do { const size_t tb = (size_t)b * 2048 + (size_t)(cc) * 64; \
        _Pragma("unroll") for (int i = 0; i < 2; ++i) { const int piece = tid + 512 * i, t = piece >> 4, c8 = (piece & 15) * 8; \
            rq[i] = *(const u32x4*)(MLQ + (tb + t) * 1024 + h * 128 + c8); rk[i] = *(const u32x4*)(MLK + (tb + t) * 1024 + h * 128 + c8); rv[i] = *(const u32x4*)(MLV + (tb + t) * 2048 + vcol + c8); } \
        if (wid == 0) { gi = GATES[(tb + lane) * 64 + h]; gf = GATES[(tb + lane) * 64 + 8 + h]; } } while (0)
    ML_LOAD(0);
    __syncthreads();
#pragma unroll 1
    for (int c = 0; c < 32; ++c) {
        const size_t t0 = (size_t)b * 2048 + (size_t)c * 64;
#pragma unroll
        for (int i = 0; i < 2; ++i) { const int piece = tid + 512 * i, t = piece >> 4, c8 = (piece & 15) * 8;
            *(u32x4*)(sq + t * 136 + c8) = rq[i]; *(u32x4*)(sk + t * 136 + c8) = rk[i];
#pragma unroll
            for (int e = 0; e < 8; ++e) sVt[(c8 + e) * 72 + t] = (bf16_t)((rv[i][e >> 1] >> ((e & 1) * 16)) & 0xffffu); }
        if (wid == 0) {
            const float ipre = softcapf_(gi + ibias); const float fc = softcapf_(gf + fbias); const float lf = fminf(fc, 0.f) - log1pf(__expf(-fabsf(fc)));
            const float bcum = wave_incl_sum(lf, lane); const float a = ipre - bcum; const float pm = wave_incl_max(a, lane);
            const float bl = __shfl(bcum, 63), pml = __shfl(pm, 63);
            const float il = bcum + m_run, mt = fmaxf(il, bcum + pm);
            const float mnew = fmaxf(bl + m_run, bl + pml);
            s_bcum[lane] = bcum; s_a[lane] = a; s_mt[lane] = mt; s_iw[lane] = __expf(il - mt); s_emt[lane] = __expf(-mt); s_ew[lane] = __expf(bl + a - mnew);
            if (lane == 0) s_sc[0] = __expf(bl + m_run - mnew);
            m_run = mnew;
        }
        if (c + 1 < 32) ML_LOAD(c + 1);
        __syncthreads();
#pragma unroll
        for (int i = 0; i < 2; ++i) { const int piece = tid + 512 * i, t = piece >> 4, c8 = (piece & 15) * 8; float f[8]; unpack8(*(const u32x4*)(sk + t * 136 + c8), f); const float ew = s_ew[t];
#pragma unroll
            for (int e = 0; e < 8; ++e) skwT[(c8 + e) * 72 + t] = f2bf(f[e] * ew); }
        { const int tr = wid >> 1, tcb = (wid & 1) * 2;
#pragma unroll
            for (int ti = 0; ti < 2; ++ti) { const int tc = tcb + ti; f32x4 a = {0.f, 0.f, 0.f, 0.f};
                if (tc <= tr) mma16<4>(a, sq, 136, tr * 16, sk, 136, tc * 16, lane);
#pragma unroll
                for (int reg = 0; reg < 4; ++reg) { const int t = tr * 16 + q * 4 + reg, s = tc * 16 + cl;
                    const float w = (s <= t) ? __expf(s_bcum[t] + s_a[s] - s_mt[t]) * a[reg] : 0.f;
                    sP[t * 72 + s] = f2bf(w); } } }
        __syncthreads();
        { const int tr = wid & 3, hb = (wid >> 2) * 4, tq = tr * 16 + q * 4;
            f32x4 an[5];
#pragma unroll
            for (int j = 0; j < 5; ++j) { const int nt = j < 4 ? hb + j : 8; an[j] = (f32x4){0.f, 0.f, 0.f, 0.f}; mma16<4>(an[j], sq, 136, tr * 16, sCt, 136, nt * 16, lane); asm volatile("" ::: "memory"); }
            f32x4 iw; iw[0] = s_iw[tq]; iw[1] = s_iw[tq + 1]; iw[2] = s_iw[tq + 2]; iw[3] = s_iw[tq + 3];
#pragma unroll
            for (int j = 0; j < 5; ++j) { const int nt = j < 4 ? hb + j : 8; an[j] *= iw; mma16<2>(an[j], sP, 72, tr * 16, sVt, 72, nt * 16, lane); }
            float rden[4];
#pragma unroll
            for (int reg = 0; reg < 4; ++reg) { const float den = __shfl(an[4][reg], lane & 48); rden[reg] = 1.f / fmaxf(fabsf(den), s_emt[tq + reg]); }
#pragma unroll
            for (int j = 0; j < 4; ++j) { const int dv = (hb + j) * 16 + cl;
#pragma unroll
                for (int reg = 0; reg < 4; ++reg) MLV[(t0 + tq + reg) * 2048 + vcol + dv] = f2bf(an[j][reg] * rden[reg]); }
            const float decay = s_sc[0];
#pragma unroll
            for (int nt = 0; nt < 9; ++nt) { accC[nt] *= decay; mma16<2>(accC[nt], skwT, 72, wid * 16, sVt, 72, nt * 16, lane); if (nt & 1) asm volatile("" ::: "memory"); }
        }
        __syncthreads();
#pragma unroll
        for (int nt = 0; nt < 9; ++nt) { const int dv = nt * 16 + cl, dk0 = wid * 16 + q * 4; u32x2 w; w.x = pk(accC[nt][0], accC[nt][1]); w.y = pk(accC[nt][2], accC[nt][3]); *(u32x2*)(sCt + dv * 136 + dk0) = w; }
    }
#undef ML_LOAD
    __syncthreads();
}

DI void p4_normgate(const Params& p) {
    const int tid = threadIdx.x, lane = tid & 63, wid = tid >> 6;
    bf16_t* MLV = (bf16_t*)(p.ws + OFF_MLV); const bf16_t* OZ = (const bf16_t*)(p.ws + OFF_OZ);
    const bf16_t* DNQKV = (const bf16_t*)(p.ws + OFF_DNQKV); const bf16_t* SDZ = (const bf16_t*)(p.ws + OFF_SDZ); bf16_t* AB = (bf16_t*)(p.ws + OFF_MLQ);
    for (int tok = blockIdx.x * 8 + wid; tok < T_TOK; tok += gridDim.x * 8) {
#pragma unroll
        for (int it = 0; it < 4; ++it) { const int c0 = it * 512 + lane * 8; float hv[8], gv[8];
            unpack8(*(const u32x4*)(MLV + (size_t)tok * 2048 + c0), hv); unpack8(*(const u32x4*)(OZ + (size_t)tok * 2048 + c0), gv);
            float ss = 0.f;
#pragma unroll
            for (int e = 0; e < 8; ++e) ss += hv[e] * hv[e];
            ss += __shfl_xor(ss, 1); ss += __shfl_xor(ss, 2); ss += __shfl_xor(ss, 4); ss += __shfl_xor(ss, 8); ss += __shfl_xor(ss, 16);
            const float rs = rsqrtf(ss * (1.f / 256.f) + EPS);
            const float4 w0 = *(const float4*)(p.ml_norm_w + c0), w1 = *(const float4*)(p.ml_norm_w + c0 + 4);
            const float w[8] = {w0.x, w0.y, w0.z, w0.w, w1.x, w1.y, w1.z, w1.w};
#pragma unroll
            for (int e = 0; e < 8; ++e) hv[e] = hv[e] * rs * w[e] * gv[e];
            *(u32x4*)(MLV + (size_t)tok * 2048 + c0) = pack8(hv); }
#pragma unroll
        for (int it = 0; it < 4; ++it) { const int c0 = it * 512 + lane * 8; float hv[8], gv[8];
            unpack8(*(const u32x4*)(DNQKV + (size_t)tok * 6144 + 4096 + c0), hv); unpack8(*(const u32x4*)(SDZ + (size_t)tok * 2048 + c0), gv);
            float ss = 0.f;
#pragma unroll
            for (int e = 0; e < 8; ++e) ss += hv[e] * hv[e];
            ss += __shfl_xor(ss, 1); ss += __shfl_xor(ss, 2); ss += __shfl_xor(ss, 4); ss += __shfl_xor(ss, 8);
            const float rs = rsqrtf(ss * (1.f / 128.f) + EPS);
            const float4 w0 = *(const float4*)(p.dn_norm_w + (c0 & 127)), w1 = *(const float4*)(p.dn_norm_w + (c0 & 127) + 4);
            const float w[8] = {w0.x, w0.y, w0.z, w0.w, w1.x, w1.y, w1.z, w1.w};
#pragma unroll
            for (int e = 0; e < 8; ++e) hv[e] = hv[e] * rs * w[e] * gv[e];
            *(u32x4*)(AB + (size_t)tok * 2048 + c0) = pack8(hv); }
    }
}

DI void p6_final(const Params& p) {
    const int tid = threadIdx.x, lane = tid & 63, wid = tid >> 6;
    const float* rowss = (const float*)(p.ws + OFF_ROWSS);
    for (int tok = blockIdx.x * 8 + wid; tok < T_TOK; tok += gridDim.x * 8) {
        const float rs = rsqrtf(rowss[tok] * (1.f / 2048.f) + EPS);
        float4* o = (float4*)(p.out + (size_t)tok * 2048);
#pragma unroll
        for (int i = 0; i < 8; ++i) { float4 v = o[i * 64 + lane]; const float4 w = ((const float4*)p.final_norm_w)[i * 64 + lane];
            v.x *= rs * w.x; v.y *= rs * w.y; v.z *= rs * w.z; v.w *= rs * w.w; o[i * 64 + lane] = v; }
    }
}


#ifdef DBG
DI void p7_debug(const Params& p) {
    const bf16_t* MLV = (const bf16_t*)(p.ws + OFF_MLV); const bf16_t* MLQ = (const bf16_t*)(p.ws + OFF_MLQ); const bf16_t* MLK = (const bf16_t*)(p.ws + OFF_MLK);
    const bf16_t* OZ = (const bf16_t*)(p.ws + OFF_OZ); const bf16_t* DNQKV = (const bf16_t*)(p.ws + OFF_DNQKV); const bf16_t* SDZ = (const bf16_t*)(p.ws + OFF_SDZ);
    const float* GATES = (const float*)(p.ws + OFF_GATES); const bf16_t* WK = (const bf16_t*)(p.ws + OFF_WK); const bf16_t* QK = (const bf16_t*)(p.ws + OFF_QK);
    const float* GE = (const float*)(p.ws + OFF_GE); const bf16_t* AB = (const bf16_t*)(p.ws + OFF_MLQ);
    for (size_t i = (size_t)blockIdx.x * 512 + threadIdx.x; i < (size_t)T_TOK * 2048; i += (size_t)gridDim.x * 512) {
        const size_t t = i >> 11; const int c = (int)(i & 2047); float v = 0.f;
#if DBG == 1
        const unsigned pr = ((const unsigned*)p.out)[i];
        v = bf2f(MLV[t * 2048 + c]) + bf2f(OZ[t * 2048 + c]) + bf2f(SDZ[t * 2048 + c]) + bf2f(DNQKV[t * 6144 + c]) + bf2f(DNQKV[t * 6144 + 2048 + c]) + bf2f(DNQKV[t * 6144 + 4096 + c])
          + bf2f(MLQ[t * 1024 + (c & 1023)]) + bf2f(MLK[t * 1024 + (c & 1023)]) + GATES[t * 64 + (c & 63)] + bflo(pr) + bfhi(pr);
#elif DBG == 2
        v = bf2f(DNQKV[t * 6144 + c]) + bf2f(DNQKV[t * 6144 + 2048 + c]) + bf2f(DNQKV[t * 6144 + 4096 + c]) + bf2f(WK[t * 2048 + c]) + bf2f(QK[t * 1024 + (c & 1023)]) + GE[(t >> 6) * 16 + (c & 15)];
#elif DBG == 3
        v = bf2f(MLV[t * 2048 + c]) + bf2f(DNQKV[t * 6144 + 4096 + c]);
#elif DBG == 4
        v = bf2f(MLV[t * 2048 + c]) + bf2f(AB[t * 2048 + c]);
#elif DBG == 5
        v = bf2f(MLV[t * 2048 + c]);
#elif DBG == 6
        v = bf2f(DNQKV[t * 6144 + 4096 + c]);
#endif
        p.out[i] = v;
    }
}
#endif
__global__ void __launch_bounds__(512) hybrid_fwd(Params p) {
    extern __shared__ __attribute__((aligned(16))) unsigned char lds[];
    cg::grid_group grid = cg::this_grid();
    const int lo = p.ph_lo, hi = p.ph_hi;
#ifndef PH_MASK
#define PH_MASK 127
#endif
#define IN(k) (((PH_MASK >> (k)) & 1) && lo <= (k) && (k) < hi)
#define SEAM(k) do { if (IN(k) && IN((k) + 1)) grid.sync(); } while (0)
    if (IN(0)) p0_prologue(p, lds);
    SEAM(0);
    if (IN(1)) {
        pg8::Gemm g{(const pg8::bf16_t*)(p.ws + OFF_U), (const pg8::bf16_t*)(p.ws + OFF_WT), T_TOK, NPAD, 2048};
        pg8::StaticOrder S; S.init(T_TOK, NPAD, (int)gridDim.x, (int)blockIdx.x);
        EpiProj E{p.ws, (unsigned*)p.out};
        pg8::gemm_phase<EpiProj, pg8::StaticOrder>((PG8_LAS unsigned char*)lds, g, S, E, nullptr);
    }
    SEAM(1);
    if (IN(2)) p2_dnprep(p, lds);
    SEAM(2);
    if (IN(3)) {
#ifndef NO_DN
        for (int item = blockIdx.x; item < 256; item += gridDim.x) if (item < 128) scan_dn(p, lds, item);
#endif
#ifndef NO_ML
        for (int item = blockIdx.x; item < 256; item += gridDim.x) if (item >= 128) scan_ml(p, lds, item - 128);
#endif
    }
    SEAM(3);
    if (IN(4)) p4_normgate(p);
    SEAM(4);
    if (IN(5)) {
        pg8::Gemm g{(const pg8::bf16_t*)(p.ws + OFF_MLV), (const pg8::bf16_t*)(p.ws + OFF_WOT), 2 * T_TOK, 4096, 2048};
        OutOrder S; S.so.init(T_TOK, 2048, (int)gridDim.x, (int)blockIdx.x);
        EpiOut E{p.x, p.out, (float*)(p.ws + OFF_PBUF), (float*)(p.ws + OFF_ROWSS)};
        pg8::gemm_phase<EpiOut, OutOrder>((PG8_LAS unsigned char*)lds, g, S, E, nullptr);
    }
    SEAM(5);
    if (IN(6)) p6_final(p);
#ifdef DBG
    if (lo == 7) p7_debug(p);
#endif
#undef IN
#undef SEAM
}

#ifndef N_LAUNCHES
#define N_LAUNCHES 7
#endif
extern "C" void kernel_launch(void* const* d_in, const int* in_sizes, int n_in, void* d_out, int out_size, void* d_ws, size_t ws_size, hipStream_t stream) {
    static int grid = 0;
    if (grid == 0) {
        if (n_in != 12 || out_size != T_TOK * DM || ws_size < WS_END) { fprintf(stderr, "kernel_launch: bad shapes / workspace (%zu < %zu)\n", ws_size, (size_t)WS_END); grid = -1; return; }
        int dev = 0, cus = 0, per_cu = 0;
        hipGetDevice(&dev); hipDeviceGetAttribute(&cus, hipDeviceAttributeMultiprocessorCount, dev);
        if (hipFuncSetAttribute((const void*)hybrid_fwd, hipFuncAttributeMaxDynamicSharedMemorySize, LDS_BYTES) != hipSuccess) { fprintf(stderr, "hipFuncSetAttribute failed\n"); grid = -1; return; }
        if (hipOccupancyMaxActiveBlocksPerMultiprocessor(&per_cu, (const void*)hybrid_fwd, 512, LDS_BYTES) != hipSuccess || per_cu < 1) { fprintf(stderr, "occupancy query: %d\n", per_cu); per_cu = 1; }
        (void)hipGetLastError();
        grid = cus * 1;
    }
    if (grid < 0) return;
    Params p{};
    p.x = (const float*)d_in[0]; p.norm_w = (const float*)d_in[1]; p.w_in = (const float*)d_in[2]; p.ml_i_bias = (const float*)d_in[3]; p.ml_f_bias = (const float*)d_in[4];
    p.ml_norm_w = (const float*)d_in[5]; p.dn_conv_w = (const float*)d_in[6]; p.dn_a_log = (const float*)d_in[7]; p.dn_dt_bias = (const float*)d_in[8]; p.dn_norm_w = (const float*)d_in[9];
    p.w_out = (const float*)d_in[10]; p.final_norm_w = (const float*)d_in[11]; p.out = (float*)d_out; p.ws = (unsigned char*)d_ws;
#if N_LAUNCHES == 1
    p.ph_lo = 0; p.ph_hi = 7;
    void* args[] = {&p};
    hipError_t e = hipLaunchCooperativeKernel((const void*)hybrid_fwd, dim3(grid), dim3(512), args, LDS_BYTES, stream);
    if (e != hipSuccess) fprintf(stderr, "cooperative launch failed: %s (grid %d)\n", hipGetErrorString(e), grid);
#else
#ifdef DBG
    const int nph = (DBG == 1) ? 2 : (DBG == 2) ? 3 : (DBG == 4) ? 5 : 4;
    for (int ph = 0; ph < nph; ++ph) { p.ph_lo = ph; p.ph_hi = ph + 1; hipLaunchKernelGGL(hybrid_fwd, dim3(grid), dim3(512), LDS_BYTES, stream, p); }
    p.ph_lo = 7; p.ph_hi = 8; hipLaunchKernelGGL(hybrid_fwd, dim3(grid), dim3(512), LDS_BYTES, stream, p);
#else
    for (int ph = 0; ph < 7; ++ph) { p.ph_lo = ph; p.ph_hi = ph + 1; hipLaunchKernelGGL(hybrid_fwd, dim3(grid), dim3(512), LDS_BYTES, stream, p); }
#endif
#endif
}
```

```cpp
#define N_LAUNCHES 1
#include <hip/hip_runtime.h>
#include <hip/hip_cooperative_groups.h>
#include <cstdio>
namespace cg = cooperative_groups;
#define XB_TMO      128
#define XB_XCNT(j)  (256  + 64 * (j))
#define XB_XSUB(j)  (1280 + 64 * (j))
#define XB_XGEN(j)  (2304 + 64 * (j))
#define XB_TOP      3328
#define XB_TOPGEN   3392
#define XCD_BAR_WORDS 3456
#define XB_SPIN_CAP (1u << 18)
#define LAS __attribute__((address_space(3)))

__device__ __forceinline__ unsigned xb_ld(unsigned* p)              { return __hip_atomic_load(p, __ATOMIC_RELAXED, __HIP_MEMORY_SCOPE_AGENT); }
__device__ __forceinline__ unsigned xb_add(unsigned* p, unsigned v) { return __hip_atomic_fetch_add(p, v, __ATOMIC_RELAXED, __HIP_MEMORY_SCOPE_AGENT); }
__device__ __forceinline__ unsigned xb_xcc_id() { return (unsigned)__builtin_amdgcn_s_getreg((3 << 11) | 20) & 0xFu; }
#define XB_SPIN(cond, bar) do { unsigned _sp = 0; while (cond) { __builtin_amdgcn_s_sleep(1); \
    if ((++_sp & 255u) == 0u) { if (xb_ld(&(bar)[XB_TMO])) break; if (_sp > XB_SPIN_CAP) { atomicAdd(&(bar)[XB_TMO], 1u); break; } } } } while (0)

struct XcdBarrier {
    unsigned* bar; unsigned x;
    volatile LAS unsigned* st;
};

__device__ __forceinline__ XcdBarrier xcd_barrier_post(unsigned* bar, volatile LAS unsigned* st) {
    XcdBarrier b; b.bar = bar; b.x = xb_xcc_id(); b.st = st;
    if (threadIdx.x == 0) (void)xb_add(&bar[XB_XCNT(b.x)], 1u);
    return b;
}
__device__ __forceinline__ void xcd_barrier_complete(unsigned* bar, unsigned x, unsigned& nloc, unsigned& nx) {
    const unsigned G = gridDim.x * gridDim.y * gridDim.z;
    unsigned sum, cnt, mine, sp = 0u;
    for (;;) {
        sum = 0u; cnt = 0u; mine = 0u;
#pragma unroll
        for (unsigned j = 0; j < 16; ++j) { const unsigned c = xb_ld(&bar[XB_XCNT(j)]); sum += c; cnt += (c > 0u) ? 1u : 0u; mine = (j == x) ? c : mine; }
        if (sum == G) break;
        __builtin_amdgcn_s_sleep(1);
        if ((++sp & 255u) == 0u) { if (xb_ld(&bar[XB_TMO])) break; if (sp > XB_SPIN_CAP) { atomicAdd(&bar[XB_TMO], 1u); break; } }
    }
    nloc = mine > 0u ? mine : 1u; nx = cnt > 0u ? cnt : 1u;
}

__device__ __forceinline__ void xcd_barrier(const XcdBarrier& b) {
    asm volatile("s_waitcnt vmcnt(0)" ::: "memory");
    __syncthreads();
    if (threadIdx.x == 0) {
        unsigned* bar = b.bar;
        __builtin_amdgcn_s_waitcnt(0);
        unsigned nloc = b.st[0], nx = b.st[1];
        if (nloc == 0u) { xcd_barrier_complete(bar, b.x, nloc, nx); b.st[0] = nloc; b.st[1] = nx; }
        const unsigned old = xb_add(&bar[XB_XSUB(b.x)], 1u);
        const unsigned gen = old / nloc;
        if (old + 1u == (gen + 1u) * nloc) {
            __builtin_amdgcn_fence(__ATOMIC_RELEASE, "agent");
            asm volatile("s_waitcnt vmcnt(0)" ::: "memory");
            const unsigned og = xb_add(&bar[XB_TOP], 1u);
            const unsigned tg = og / nx;
            if (og + 1u == (tg + 1u) * nx) xb_add(&bar[XB_TOPGEN], 1u);
            else XB_SPIN(xb_ld(&bar[XB_TOPGEN]) == tg, bar);
            __builtin_amdgcn_fence(__ATOMIC_ACQUIRE, "agent");
            xb_add(&bar[XB_XGEN(b.x)], 1u);
            asm volatile("s_waitcnt vmcnt(0)" ::: "memory");
        } else {
            XB_SPIN(xb_ld(&bar[XB_XGEN(b.x)]) == gen, bar);
            __builtin_amdgcn_fence(__ATOMIC_ACQUIRE, "agent");
            asm volatile("s_waitcnt vmcnt(0)" ::: "memory");
        }
    }
    __syncthreads();
}
namespace pg8 {
#define PG8_LAS __attribute__((address_space(3)))
typedef unsigned short bf16_t;
typedef short bf16x8 __attribute__((ext_vector_type(8)));
typedef float f32x4 __attribute__((ext_vector_type(4)));
typedef unsigned u32x4 __attribute__((ext_vector_type(4)));
constexpr int BM = 256, BK = 64, HALF = 128, HTB = HALF * BK * 2  , STAGE_BYTES = 8 * HTB, NXCD = 8, WGM = 8;

__host__ __device__ __forceinline__ int lds_byte(int r, int c) { const int st = (r >> 4) * 2 + (c >> 5), rr = r & 15, cc = c & 31, ob = rr * 64 + cc * 2; return st * 1024 + (ob ^ (((ob >> 9) & 1) << 5)); }
__host__ __device__ __forceinline__ void stage_rc(int b, int& R, int& C) { const int st = b / 1024, sb = b % 1024, swz = sb ^ (((sb >> 9) & 1) << 5); R = (st >> 1) * 16 + swz / 64; C = (st & 1) * 32 + (swz % 64) / 2; }
__host__ __device__ __forceinline__ int perm32(int rho) { const int n = rho >> 4, i = rho & 15; return 8 * (i >> 2) + 4 * n + (i & 3); }

struct Unit { int pm, pn; };
struct Gemm { const bf16_t* A; const bf16_t* Bt; int M, N, K; };

struct StaticOrder {
    int nM, nN, nwg, G, c;
    __host__ __device__ void init(int M, int N, int G_, int c_) { nM = M / BM; nN = N / BM; nwg = nM * nN; G = G_; c = c_; }
    __host__ __device__ bool next(int i, Unit& u) const {
        const long L = (long)i * G + c; if (L >= nwg) return false;
        int wgid = (int)L; { const int q = nwg / NXCD, r = nwg % NXCD, xcd = wgid % NXCD, off = wgid / NXCD; wgid = (xcd < r ? xcd * (q + 1) : r * (q + 1) + (xcd - r) * q) + off; }
        const int nig = WGM * nN, gid = wgid / nig, fm = gid * WGM, gsz = (nM - fm) < WGM ? (nM - fm) : WGM;
        u.pm = fm + ((wgid % nig) % gsz); u.pn = (wgid % nig) / gsz; return true;
    }
    __device__ __forceinline__ void a_ready(const Unit&) const {}
    __device__ __forceinline__ void done(const Unit&) const {}
};
__device__ __forceinline__ unsigned cvt_pk_bf16(float lo, float hi) { unsigned r; asm volatile("v_cvt_pk_bf16_f32 %0, %1, %2" : "=v"(r) : "v"(lo), "v"(hi)); return r; }
template <class Epi, class Sched, bool STAMP = false>
__device__ __forceinline__ void gemm_phase(PG8_LAS unsigned char* lds, const Gemm g, const Sched& S, const Epi& E, unsigned long long* stamps) {
    const int tid = threadIdx.x, wid = __builtin_amdgcn_readfirstlane(tid >> 6), lane = tid & 63, wr = wid >> 2, wc = wid & 3, fr = lane & 15, fq = lane >> 4;
    const int K = g.K, nt = K / BK;
    int ts_lo = 0, ts_hi = 0, nts = 0; const unsigned long long rt_entry = STAMP ? (unsigned long long)wall_clock64() : 0ull;
#define PG8_STAMP() do { if (STAMP && wid == 0 && nts < 64) { const unsigned long long _c = (unsigned long long)clock64(); \
        ts_lo = (lane == nts) ? (int)(unsigned)_c : ts_lo; ts_hi = (lane == nts) ? (int)(unsigned)(_c >> 32) : ts_hi; ++nts; } } while (0)
    PG8_STAMP();
    unsigned voffA[2], voffB[2];
#pragma unroll
    for (int i = 0; i < 2; ++i) { int R, C; stage_rc(tid * 16 + i * 8192, R, C); const int Rb = Epi::PERM ? ((R & ~31) + perm32(R & 31)) : R;
        voffA[i] = (unsigned)(R * K + C) * 2u; voffB[i] = (unsigned)(Rb * K + C) * 2u; }
    const size_t kstep = (size_t)(BK * 2);
    const size_t hstep = (size_t)HALF * K * 2;
    const size_t tstep = 2 * hstep;
    const unsigned ldsw = (unsigned)wid * 1024u;
    const int aoff = lds_byte(wr * 64 + fr, fq * 8), boff = lds_byte(wc * 32 + fr, fq * 8);
#define PG8_SA(b, h) (((b) * 2 + (h)) * HTB)
#define PG8_SB(b, h) ((4 + (b) * 2 + (h)) * HTB)
#define PG8_STAGE(bufoff, gbase, voff) do { _Pragma("unroll") for (int _i = 0; _i < 2; ++_i) \
        __builtin_amdgcn_global_load_lds((const unsigned*)((const char*)(gbase) + (voff)[_i]), (PG8_LAS unsigned*)(lds + (bufoff) + ldsw + _i * 8192), 16, 0, 0); } while (0)
#define PG8_LDA(dst, b, h) do { _Pragma("unroll") for (int m = 0; m < 4; ++m) _Pragma("unroll") for (int k = 0; k < 2; ++k) dst[m][k] = *(const PG8_LAS bf16x8*)(lds + PG8_SA(b, h) + aoff + m * 2048 + k * 1024); } while (0)
#define PG8_LDB(dst, b, h) do { _Pragma("unroll") for (int n = 0; n < 2; ++n) _Pragma("unroll") for (int k = 0; k < 2; ++k) dst[n][k] = *(const PG8_LAS bf16x8*)(lds + PG8_SB(b, h) + boff + n * 2048 + k * 1024); } while (0)
#define PG8_MMA(ai, bj, At, Bt) do { __builtin_amdgcn_s_setprio(1); _Pragma("unroll") for (int m = 0; m < 4; ++m) _Pragma("unroll") for (int n = 0; n < 2; ++n) _Pragma("unroll") for (int k = 0; k < 2; ++k) \
        acc[ai][bj][m][n] = __builtin_amdgcn_mfma_f32_16x16x32_bf16(Bt[n][k], At[m][k], acc[ai][bj][m][n], 0, 0, 0); __builtin_amdgcn_s_setprio(0); } while (0)
#define PG8_WAIT_V(n) asm volatile("s_waitcnt vmcnt(" #n ")" ::: "memory")
#define PG8_WAIT_L(n) asm volatile("s_waitcnt lgkmcnt(" #n ")" ::: "memory")
#define PG8_BAR __builtin_amdgcn_s_barrier()
#define PG8_SCHED __builtin_amdgcn_sched_barrier(0)
    Unit cur, nxt; int ui = 0;
    if (!S.next(0, cur)) return;
    f32x4 acc[2][2][4][2];
#pragma unroll
    for (int a = 0; a < 2; ++a)
#pragma unroll
        for (int b = 0; b < 2; ++b)
#pragma unroll
            for (int m = 0; m < 4; ++m)
#pragma unroll
                for (int n = 0; n < 2; ++n) acc[a][b][m][n] = (f32x4){0.f, 0.f, 0.f, 0.f};
    bf16x8 At[4][2], B0[2][2], B1[2][2];
    const char* cA = (const char*)g.A + (size_t)cur.pm * tstep; const char* cB = (const char*)g.Bt + (size_t)cur.pn * tstep;
    S.a_ready(cur);
    PG8_STAGE(PG8_SB(0, 0), cB, voffB); PG8_STAGE(PG8_SA(0, 0), cA, voffA); PG8_STAGE(PG8_SB(0, 1), cB + hstep, voffB); PG8_STAGE(PG8_SA(0, 1), cA + hstep, voffA);
    if (wr == 1) PG8_BAR;
    PG8_WAIT_V(4); PG8_BAR;
    PG8_STAGE(PG8_SB(1, 0), cB + kstep, voffB); PG8_STAGE(PG8_SA(1, 0), cA + kstep, voffA); PG8_STAGE(PG8_SB(1, 1), cB + hstep + kstep, voffB);
    PG8_WAIT_V(6); PG8_BAR;
    PG8_STAMP();
    for (;;) {
        const bool has_next = S.next(ui + 1, nxt);
        const char* nA = has_next ? (const char*)g.A + (size_t)nxt.pm * tstep : cA; const char* nB = has_next ? (const char*)g.Bt + (size_t)nxt.pn * tstep : cB;
        for (int t = 0; t < nt; t += 2) {
            const bool last = (t == nt - 2);
            const char* a1 = cA + (size_t)(t + 1) * kstep;
            const char* a2 = last ? nA : cA + (size_t)(t + 2) * kstep; const char* b2 = last ? nB : cB + (size_t)(t + 2) * kstep;
            const char* a3 = a2 + kstep; const char* b3 = b2 + kstep;
            if (last && has_next) S.a_ready(nxt);
            PG8_LDB(B0, 0, 0); PG8_SCHED; PG8_LDA(At, 0, 0); PG8_STAGE(PG8_SA(1, 1), a1 + hstep, voffA);
            PG8_WAIT_L(8); PG8_BAR; PG8_WAIT_L(0); PG8_MMA(0, 0, At, B0); PG8_BAR; PG8_SCHED;
            PG8_LDB(B1, 0, 1); PG8_STAGE(PG8_SB(0, 0), b2, voffB);
            PG8_BAR; PG8_WAIT_L(0); PG8_MMA(0, 1, At, B1); PG8_BAR;
            PG8_LDA(At, 0, 1); PG8_STAGE(PG8_SA(0, 0), a2, voffA);
            PG8_BAR; PG8_WAIT_L(0); PG8_MMA(1, 0, At, B0); PG8_BAR; PG8_SCHED;
            PG8_STAGE(PG8_SB(0, 1), b2 + hstep, voffB);
            PG8_WAIT_V(6); PG8_BAR; PG8_MMA(1, 1, At, B1); PG8_BAR;
            PG8_LDB(B0, 1, 0); PG8_SCHED; PG8_LDA(At, 1, 0); PG8_STAGE(PG8_SA(0, 1), a2 + hstep, voffA);
            PG8_WAIT_L(8); PG8_BAR; PG8_WAIT_L(0); PG8_MMA(0, 0, At, B0); PG8_BAR; PG8_SCHED;
            PG8_LDB(B1, 1, 1); PG8_STAGE(PG8_SB(1, 0), b3, voffB);
            PG8_BAR; PG8_WAIT_L(0); PG8_MMA(0, 1, At, B1); PG8_BAR;
            PG8_LDA(At, 1, 1); PG8_STAGE(PG8_SA(1, 0), a3, voffA);
            PG8_BAR; PG8_WAIT_L(0); PG8_MMA(1, 0, At, B0); PG8_BAR; PG8_SCHED;
            PG8_STAGE(PG8_SB(1, 1), b3 + hstep, voffB);
            PG8_WAIT_V(6); PG8_BAR; PG8_MMA(1, 1, At, B1); PG8_BAR;
        }
        PG8_STAMP();
        bool keep_acc = false;
        if constexpr (!Epi::AFTER_DRAIN) { keep_acc = E(acc, cur, wr, wc, fr, fq); S.done(cur); }
        PG8_STAMP();
        if (!has_next) break;
        if (!keep_acc)
#pragma unroll
        for (int a = 0; a < 2; ++a)
#pragma unroll
            for (int b = 0; b < 2; ++b)
#pragma unroll
                for (int m = 0; m < 4; ++m)
#pragma unroll
                    for (int n = 0; n < 2; ++n) acc[a][b][m][n] = (f32x4){0.f, 0.f, 0.f, 0.f};
        cur = nxt; cA = nA; cB = nB; ++ui;
    }
    PG8_WAIT_V(0);
    if (wr == 0) PG8_BAR;
    PG8_BAR;
    if constexpr (Epi::AFTER_DRAIN) { E.fused(acc, cur, wr, wc, fr, fq, lds, wid, lane); S.done(cur); }
    PG8_STAMP();
    if (STAMP && wid == 0) { stamps[lane] = lane < nts ? (((unsigned long long)(unsigned)ts_hi << 32) | (unsigned)ts_lo) : 0ull;
        if (lane == 62) stamps[62] = rt_entry; if (lane == 63) stamps[63] = (unsigned long long)wall_clock64(); }
#undef PG8_STAMP
#undef PG8_SA
#undef PG8_SB
#undef PG8_STAGE
#undef PG8_LDA
#undef PG8_LDB
#undef PG8_MMA
#undef PG8_WAIT_V
#undef PG8_WAIT_L
#undef PG8_BAR
#undef PG8_SCHED
}
}

#define DI __device__ __forceinline__
typedef unsigned short bf16_t;
typedef short bf16x8 __attribute__((ext_vector_type(8)));
typedef float f32x4 __attribute__((ext_vector_type(4)));
typedef unsigned u32x4 __attribute__((ext_vector_type(4)));
typedef unsigned u32x2 __attribute__((ext_vector_type(2)));

constexpr int T_TOK = 16384, DM = 2048, IN_DIM = 20528, NPAD = 20736;
constexpr int LDS_BYTES = 152 * 1024;
constexpr float EPS = 1e-6f;

constexpr size_t SZ_T2048 = (size_t)T_TOK * 2048 * 2;
constexpr size_t OFF_WT = 0;
constexpr size_t OFF_QK = 0;
constexpr size_t OFF_U = OFF_WT + (size_t)NPAD * 2048 * 2;
constexpr size_t OFF_WK = OFF_U;
constexpr size_t OFF_MLV = OFF_U + SZ_T2048;
constexpr size_t OFF_MLQ = OFF_MLV + SZ_T2048;
constexpr size_t OFF_MLK = OFF_MLQ + SZ_T2048 / 2;
constexpr size_t OFF_OZ = OFF_MLK + SZ_T2048 / 2;
constexpr size_t OFF_DNQKV = OFF_OZ + SZ_T2048;
constexpr size_t OFF_PBUF = OFF_DNQKV;
constexpr size_t OFF_SDZ = OFF_DNQKV + 3 * SZ_T2048;
constexpr size_t OFF_GATES = OFF_SDZ + SZ_T2048;
constexpr size_t OFF_HALO = OFF_GATES + (size_t)T_TOK * 64 * 4;
constexpr size_t OFF_WOT = OFF_HALO + (size_t)256 * 3 * 6144 * 2;
constexpr size_t OFF_ROWSS = OFF_WOT + (size_t)2 * 2048 * 2048 * 2;
constexpr size_t OFF_GE = OFF_ROWSS + (size_t)T_TOK * 4;
constexpr size_t OFF_BAR = OFF_GE + 4096 * 4;
constexpr size_t WS_END = OFF_BAR + (size_t)XCD_BAR_WORDS * 4;

struct Params {
    const float *x, *norm_w, *w_in, *ml_i_bias, *ml_f_bias, *ml_norm_w, *dn_conv_w, *dn_a_log, *dn_dt_bias, *dn_norm_w, *w_out, *final_norm_w;
    float* out; unsigned char* ws; int ph_lo, ph_hi; int flags, pad;
};

typedef __bf16 bf16x2_t __attribute__((ext_vector_type(2)));
typedef float f32x2_t __attribute__((ext_vector_type(2)));
DI unsigned pk(float lo, float hi) { const f32x2_t v = {lo, hi}; const bf16x2_t b = __builtin_convertvector(v, bf16x2_t); return __builtin_bit_cast(unsigned, b); }
DI bf16_t f2bf(float f) { return (bf16_t)(pk(f, 0.f) & 0xffffu); }
DI float bf2f(bf16_t b) { return __uint_as_float(((unsigned)b) << 16); }
DI float bflo(unsigned u) { return __uint_as_float(u << 16); }
DI float bfhi(unsigned u) { return __uint_as_float(u & 0xffff0000u); }
DI float sigmoidf_(float x) { return __fdividef(1.f, 1.f + __expf(-x)); }
DI float softplusf_(float x) { return fmaxf(x, 0.f) + log1pf(__expf(-fabsf(x))); }
DI float softcapf_(float x) { return 15.f * tanhf(x * (1.f / 15.f)); }
#define DPPF(old, src, ctrl, rm) __int_as_float(__builtin_amdgcn_update_dpp(__float_as_int(old), __float_as_int(src), (ctrl), (rm), 0xF, false))
DI float dpp_incl_sum(float v) {
    v += DPPF(0.f, v, 0x111, 0xF); v += DPPF(0.f, v, 0x112, 0xF); v += DPPF(0.f, v, 0x114, 0xF); v += DPPF(0.f, v, 0x118, 0xF);
    v += DPPF(0.f, v, 0x142, 0xA); v += DPPF(0.f, v, 0x143, 0xC); return v;
}
DI float dpp_incl_max(float v) {
    const float ninf = -__builtin_huge_valf();
    v = fmaxf(v, DPPF(ninf, v, 0x111, 0xF)); v = fmaxf(v, DPPF(ninf, v, 0x112, 0xF)); v = fmaxf(v, DPPF(ninf, v, 0x114, 0xF)); v = fmaxf(v, DPPF(ninf, v, 0x118, 0xF));
    v = fmaxf(v, DPPF(ninf, v, 0x142, 0xA)); v = fmaxf(v, DPPF(ninf, v, 0x143, 0xC)); return v;
}
DI float fexp(float x) { return __builtin_amdgcn_exp2f(1.4426950408889634f * x); }
DI float flog1pexp_negabs(float x) { return 0.6931471805599453f * __builtin_amdgcn_logf(1.f + __builtin_amdgcn_exp2f(-1.4426950408889634f * fabsf(x))); }
DI float fsoftcap(float x) { const float e = __builtin_amdgcn_exp2f(x * (-2.f * 1.4426950408889634f / 15.f)); return 15.f * (1.f - e) * __builtin_amdgcn_rcpf(1.f + e); }
DI float wave_sum(float v) { for (int d = 32; d >= 1; d >>= 1) v += __shfl_xor(v, d); return v; }
DI float wave_incl_sum(float v, int lane) { for (int d = 1; d < 64; d <<= 1) { float o = __shfl_up(v, d); if (lane >= d) v += o; } return v; }
DI float wave_incl_max(float v, int lane) { for (int d = 1; d < 64; d <<= 1) { float o = __shfl_up(v, d); if (lane >= d) v = fmaxf(v, o); } return v; }
DI void lds_bar() { asm volatile("s_waitcnt lgkmcnt(0)" ::: "memory"); __builtin_amdgcn_s_barrier(); asm volatile("" ::: "memory"); }
DI float row16_sum(float v) {
    v += __int_as_float(__builtin_amdgcn_update_dpp(0, __float_as_int(v), 0xB1, 0xF, 0xF, true));
    v += __int_as_float(__builtin_amdgcn_update_dpp(0, __float_as_int(v), 0x4E, 0xF, 0xF, true));
    v += __int_as_float(__builtin_amdgcn_update_dpp(0, __float_as_int(v), 0x124, 0xF, 0xF, true));
    v += __int_as_float(__builtin_amdgcn_update_dpp(0, __float_as_int(v), 0x128, 0xF, 0xF, true));
    return v;
}
DI float fast_sigmoid(float x) { return __builtin_amdgcn_rcpf(1.f + __builtin_amdgcn_exp2f(-1.4426950408889634f * x)); }
DI void unpack8(const u32x4& r, float (&f)[8]) {
#pragma unroll
    for (int e = 0; e < 4; ++e) { f[2 * e] = bflo(r[e]); f[2 * e + 1] = bfhi(r[e]); }
}
DI u32x4 pack8(const float (&f)[8]) { u32x4 r; r.x = pk(f[0], f[1]); r.y = pk(f[2], f[3]); r.z = pk(f[4], f[5]); r.w = pk(f[6], f[7]); return r; }

template <int KS> DI void mma16(f32x4& acc, const bf16_t* A, int lda, int arow0, const bf16_t* Bt, int ldb, int brow0, int lane) {
    const int r = lane & 15, q = lane >> 4;
    const bf16_t* ap = A + (arow0 + r) * lda + q * 8;
    const bf16_t* bp = Bt + (brow0 + r) * ldb + q * 8;
#pragma unroll
    for (int ks = 0; ks < KS; ++ks) {
        const bf16x8 a = *(const bf16x8*)(ap + ks * 32), b = *(const bf16x8*)(bp + ks * 32);
        acc = __builtin_amdgcn_mfma_f32_16x16x32_bf16(a, b, acc, 0, 0, 0);
    }
}

template <int KS> DI void lda16(bf16x8 (&af)[KS], const bf16_t* A, int lda, int arow0, int lane) {
    const bf16_t* ap = A + (arow0 + (lane & 15)) * lda + (lane >> 4) * 8;
#pragma unroll
    for (int ks = 0; ks < KS; ++ks) af[ks] = *(const bf16x8*)(ap + ks * 32);
}
template <int KS> DI void mma16r(f32x4& acc, const bf16x8 (&af)[KS], const bf16_t* Bt, int ldb, int brow0, int lane) {
    const bf16_t* bp = Bt + (brow0 + (lane & 15)) * ldb + (lane >> 4) * 8;
#pragma unroll
    for (int ks = 0; ks < KS; ++ks) { const bf16x8 b = *(const bf16x8*)(bp + ks * 32); acc = __builtin_amdgcn_mfma_f32_16x16x32_bf16(af[ks], b, acc, 0, 0, 0); }
}
template <int KS> DI void mma16rT(f32x4& acc, const bf16x8 (&af)[KS], const bf16_t* Bt, int ldb, int brow0, int lane) {
    const bf16_t* bp = Bt + (brow0 + (lane & 15)) * ldb + (lane >> 4) * 8;
#pragma unroll
    for (int ks = 0; ks < KS; ++ks) { const bf16x8 b = *(const bf16x8*)(bp + ks * 32); acc = __builtin_amdgcn_mfma_f32_16x16x32_bf16(b, af[ks], acc, 0, 0, 0); }
}
DI int src_col(int np) {
    if (np < 4096) return np;
    if (np < 8192) { const int j = (np - 4096) >> 8, r = (np - 4096) & 255; return r < 128 ? 4096 + 128 * j + r : 6144 + 128 * j + (r - 128); }
    if (np < 14336) return 8208 + (np - 8192);
    if (np < 16384) return 14352 + (np - 14336);
    if (np < 20480) { const int j = (np - 16384) >> 8, r = (np - 16384) & 255; return r < 128 ? 16432 + 128 * j + r : 18480 + 128 * j + (r - 128); }
    if (np < 20496) return 8192 + (np - 20480);
    if (np < 20528) return 16400 + (np - 20496);
    return -1;
}

DI void p0_transpose(const Params& p, unsigned char* lds, int t_lo, int t_hi, int first, int stride) {
    const int tid = threadIdx.x;
    float* tile = (float*)lds;
    constexpr int NT_IN = (NPAD / 256) * 32;
    bf16_t* Wt = (bf16_t*)(p.ws + OFF_WT); bf16_t* WoT = (bf16_t*)(p.ws + OFF_WOT);
    const int g4 = tid & 63, kr = tid >> 6;
#pragma unroll 1
    for (int tix = t_lo + first; tix < t_hi; tix += stride) {
        const float* src; size_t ld; int sc, k0; bf16_t* dst;
        if (tix < NT_IN) { const int ntile = tix >> 5, kt = tix & 31; k0 = kt * 64; sc = src_col(ntile * 256 + g4 * 4); src = p.w_in; ld = IN_DIM; dst = Wt + (size_t)ntile * 256 * 2048; }
        else { const int r = tix - NT_IN, half = r >> 8, r2 = r & 255, ntile = r2 >> 5, kt = r2 & 31; k0 = kt * 64; sc = ntile * 256 + g4 * 4; src = p.w_out + (size_t)half * 2048 * 2048; ld = 2048; dst = WoT + (size_t)half * 2048 * 2048 + (size_t)ntile * 256 * 2048; }
        f32x4 v[8];
#pragma unroll
        for (int i = 0; i < 8; ++i) v[i] = sc >= 0 ? *(const f32x4*)(src + (size_t)(k0 + i * 8 + kr) * ld + sc) : (f32x4){0.f, 0.f, 0.f, 0.f};
#pragma unroll
        for (int i = 0; i < 8; ++i) *(f32x4*)(tile + (i * 8 + kr) * 260 + g4 * 4) = v[i];
        lds_bar();
#pragma unroll
        for (int it = 0; it < 4; ++it) { const int piece = it * 512 + tid, k8 = piece >> 8, n = piece & 255; float f[8];
#pragma unroll
            for (int i = 0; i < 8; ++i) f[i] = tile[(k8 * 8 + i) * 260 + n];
            *(u32x4*)(dst + (size_t)n * 2048 + k0 + k8 * 8) = pack8(f); }
        lds_bar();
    }
}

DI void p0_prologue(const Params& p, unsigned char* lds) {
    const int tid = threadIdx.x, lane = tid & 63, wid = tid >> 6;
    float* rowss = (float*)(p.ws + OFF_ROWSS);
    for (int i = blockIdx.x * 512 + tid; i < T_TOK; i += gridDim.x * 512) rowss[i] = 0.f;
    bf16_t* U = (bf16_t*)(p.ws + OFF_U);
    const int rstep = gridDim.x * 8;
#pragma unroll 1
    for (int row = blockIdx.x * 8 + wid; row < T_TOK; row += 2 * rstep) {
        const int row2 = (row + rstep < T_TOK) ? row + rstep : row;
        const float4* xa = (const float4*)(p.x + (size_t)row * DM); const float4* xb = (const float4*)(p.x + (size_t)row2 * DM);
        float4 va[8], vb[8]; float sa = 0.f, sb = 0.f;
#pragma unroll
        for (int i = 0; i < 8; ++i) { va[i] = xa[i * 64 + lane]; vb[i] = xb[i * 64 + lane]; }
#pragma unroll
        for (int i = 0; i < 8; ++i) { sa += va[i].x * va[i].x + va[i].y * va[i].y + va[i].z * va[i].z + va[i].w * va[i].w; sb += vb[i].x * vb[i].x + vb[i].y * vb[i].y + vb[i].z * vb[i].z + vb[i].w * vb[i].w; }
        sa = wave_sum(sa); sb = wave_sum(sb);
        const float ra = rsqrtf(sa * (1.f / 2048.f) + EPS), rb = rsqrtf(sb * (1.f / 2048.f) + EPS);
#pragma unroll
        for (int i = 0; i < 8; ++i) { const float4 w = ((const float4*)p.norm_w)[i * 64 + lane];
            u32x2 o; o.x = pk(va[i].x * ra * w.x, va[i].y * ra * w.y); o.y = pk(va[i].z * ra * w.z, va[i].w * ra * w.w);
            *(u32x2*)(U + (size_t)row * DM + (i * 64 + lane) * 4) = o;
            u32x2 o2; o2.x = pk(vb[i].x * rb * w.x, vb[i].y * rb * w.y); o2.y = pk(vb[i].z * rb * w.z, vb[i].w * rb * w.w);
            *(u32x2*)(U + (size_t)row2 * DM + (i * 64 + lane) * 4) = o2; }
    }
    p0_transpose(p, lds, 0, (NPAD / 256) * 32, blockIdx.x, gridDim.x);
}

struct EpiProj {
    static constexpr bool PERM = true, AFTER_DRAIN = false;
    unsigned char* ws; unsigned* dout; int flags;
    DI bool operator()(const f32x4 (&acc)[2][2][4][2], const pg8::Unit& u, int wr, int wc, int fr, int fq) const {
        if (flags & 256) return false;
        const int pn = u.pn;
        const int row0 = u.pm * 256 + wr * 64 + fr;
        const int lc = wc * 32 + 8 * fq;
        if (pn < 16 || (pn >= 32 && pn < 56)) {
            bf16_t* base; int ldc, colt; float sc = 1.f; bool halo = false;
            if (pn < 4) { base = (bf16_t*)(ws + OFF_MLQ); ldc = 1024; colt = pn * 256; sc = 0.08838834764831845f; }
            else if (pn < 8) { base = (bf16_t*)(ws + OFF_MLK); ldc = 1024; colt = (pn - 4) * 256; }
            else if (pn < 16) { base = (bf16_t*)(ws + OFF_MLV); ldc = 2048; colt = (pn - 8) * 256; }
            else { base = (bf16_t*)(ws + OFF_DNQKV); ldc = 6144; colt = (pn - 32) * 256; halo = true; }
            bf16_t* hb = (bf16_t*)(ws + OFF_HALO);
#pragma unroll
            for (int ai = 0; ai < 2; ++ai)
#pragma unroll
                for (int m = 0; m < 4; ++m) { const int row = row0 + ai * 128 + m * 16; bf16_t* rowp = base + (size_t)row * ldc + colt + lc;
#pragma unroll
                    for (int bj = 0; bj < 2; ++bj) { const f32x4 v0 = acc[ai][bj][m][0] * sc, v1 = acc[ai][bj][m][1] * sc;
                        u32x4 w; w.x = pk(v0[0], v0[1]); w.y = pk(v0[2], v0[3]); w.z = pk(v1[0], v1[1]); w.w = pk(v1[2], v1[3]);
                        *(u32x4*)(rowp + bj * 128) = w;
                        if (halo && (row & 63) >= 61) *(u32x4*)(hb + ((size_t)(row >> 6) * 3 + ((row & 63) - 61)) * 6144 + colt + lc + bj * 128) = w; } }
        } else if (pn < 32) {
            bf16_t* base = (bf16_t*)(ws + OFF_OZ) + (pn - 16) * 128 + lc;
#pragma unroll
            for (int ai = 0; ai < 2; ++ai)
#pragma unroll
                for (int m = 0; m < 4; ++m) { const int row = row0 + ai * 128 + m * 16; float f[8];
#pragma unroll
                    for (int n = 0; n < 2; ++n)
#pragma unroll
                        for (int i = 0; i < 4; ++i) { const float o = acc[ai][0][m][n][i], z = acc[ai][1][m][n][i];
                            const float eo = __builtin_amdgcn_exp2f(-1.4426950408889634f * o), ez = __builtin_amdgcn_exp2f(-1.4426950408889634f * z); f[n * 4 + i] = z * __builtin_amdgcn_rcpf((1.f + eo) * (1.f + ez)); }
                    *(u32x4*)(base + (size_t)row * 2048) = pack8(f); }
        } else if (pn < 64) {
            bf16_t* base = (bf16_t*)(ws + OFF_SDZ) + (pn - 56) * 256 + lc;
#pragma unroll
            for (int ai = 0; ai < 2; ++ai)
#pragma unroll
                for (int m = 0; m < 4; ++m) { const int row = row0 + ai * 128 + m * 16;
#pragma unroll
                    for (int bj = 0; bj < 2; ++bj) { float f[8];
#pragma unroll
                        for (int n = 0; n < 2; ++n)
#pragma unroll
                            for (int i = 0; i < 4; ++i) { const float z = acc[ai][bj][m][n][i]; f[n * 4 + i] = z * fast_sigmoid(z); }
                        *(u32x4*)(base + (size_t)row * 2048 + bj * 128) = pack8(f); } }
        } else if (pn < 80) {
            unsigned* base = dout + (pn - 64) * 128 + lc;
#pragma unroll
            for (int ai = 0; ai < 2; ++ai)
#pragma unroll
                for (int m = 0; m < 4; ++m) { const int row = row0 + ai * 128 + m * 16;
#pragma unroll
                    for (int n = 0; n < 2; ++n) { u32x4 w;
#pragma unroll
                        for (int i = 0; i < 4; ++i) { const float ea = __builtin_amdgcn_exp2f(-1.4426950408889634f * acc[ai][0][m][n][i]), eb = __builtin_amdgcn_exp2f(-1.4426950408889634f * acc[ai][1][m][n][i]);
                            const float hb = fminf(1.f + eb, 1e30f);
                            w[i] = pk(__builtin_amdgcn_rcpf(1.f + ea) * hb, hb); }
                        *(u32x4*)(base + (size_t)row * 2048 + 4 * n) = w; } }
        } else {
            if (wc < 2) { float* base = (float*)(ws + OFF_GATES) + lc;
#pragma unroll
                for (int ai = 0; ai < 2; ++ai)
#pragma unroll
                    for (int m = 0; m < 4; ++m) { const int row = row0 + ai * 128 + m * 16;
#pragma unroll
                        for (int n = 0; n < 2; ++n) *(f32x4*)(base + (size_t)row * 64 + 4 * n) = acc[ai][0][m][n]; } }
        }
        return false;
    }
};

constexpr int A_B_TILE_OFS = (int)((OFF_SDZ - OFF_MLV) / ((size_t)256 * 2048 * 2));
static_assert((OFF_SDZ - OFF_MLV) % ((size_t)256 * 2048 * 2) == 0, "A_b must sit a whole number of 256-row tiles after A_a");
struct EpiOut {
    static constexpr bool PERM = false, AFTER_DRAIN = false;
    const float* x; float* out; float* rowss;
    DI bool operator()(f32x4 (&acc)[2][2][4][2], const pg8::Unit& u, int wr, int wc, int fr, int fq) const {
        const bool half = u.pm >= 64; const int pm = half ? u.pm - A_B_TILE_OFS : u.pm, pn = u.pn & 7;
        const int row0 = pm * 256 + wr * 64 + fr, col0 = pn * 256 + wc * 32 + 4 * fq;
#pragma unroll
        for (int ai = 0; ai < 2; ++ai)
#pragma unroll
            for (int m = 0; m < 4; ++m) { const int row = row0 + ai * 128 + m * 16; const size_t off = (size_t)row * 2048 + col0; float ss = 0.f;
#pragma unroll
                for (int bj = 0; bj < 2; ++bj)
#pragma unroll
                    for (int n = 0; n < 2; ++n) { const size_t o = off + bj * 128 + n * 16; const u32x4 pr = *(const u32x4*)((const unsigned*)out + o);
                        if (!half) { f32x4 r; r[0] = bflo(pr[0]); r[1] = bflo(pr[1]); r[2] = bflo(pr[2]); r[3] = bflo(pr[3]);
                            acc[ai][bj][m][n] *= r; }
                        else { f32x4 gb; gb[0] = __builtin_amdgcn_rcpf(bfhi(pr[0])); gb[1] = __builtin_amdgcn_rcpf(bfhi(pr[1])); gb[2] = __builtin_amdgcn_rcpf(bfhi(pr[2])); gb[3] = __builtin_amdgcn_rcpf(bfhi(pr[3]));
                            const f32x4 xv = *(const f32x4*)(x + o); const f32x4 hh = xv + gb * acc[ai][bj][m][n];
                            *(f32x4*)(out + o) = hh; ss += hh[0] * hh[0] + hh[1] * hh[1] + hh[2] * hh[2] + hh[3] * hh[3]; } }
                if (half) { ss += __shfl_xor(ss, 16); ss += __shfl_xor(ss, 32); if (fq == 0) atomicAdd(rowss + row, ss); }
                asm volatile("" ::: "memory"); }
        return !half;
    }
};
struct OutOrder {
    pg8::StaticOrder so;
    DI bool next(int i, pg8::Unit& u) const { pg8::Unit t; if (!so.next(i >> 1, t)) return false; const int half = i & 1; u.pm = t.pm + A_B_TILE_OFS * half; u.pn = t.pn + 8 * half; return true; }
    DI void a_ready(const pg8::Unit&) const {}
    DI void done(const pg8::Unit&) const {}
};

DI void p2_dnprep(const Params& p, unsigned char* lds) {
    const int tid = threadIdx.x, lane = tid & 63, wid = tid >> 6, q = lane >> 4, cl = lane & 15;
    bf16_t* sraw = (bf16_t*)lds;
    float* sR = (float*)lds;
    bf16_t* sqn = (bf16_t*)(lds + 52736);
    bf16_t* skn = sqn + 64 * 136;
    bf16_t* svn = skn + 64 * 136;
    float* sA = (float*)(lds + 104960);
    float* sbeta = (float*)(lds + 125440);
    float* sgam = sbeta + 64; float* sbg = sgam + 64;
    float* scw = (float*)(lds + 126208);
    float* sT = (float*)(lds + 132352);
    bf16_t* DNQKV = (bf16_t*)(p.ws + OFF_DNQKV); const bf16_t* HALO = (const bf16_t*)(p.ws + OFF_HALO);
    const float* GATES = (const float*)(p.ws + OFF_GATES); bf16_t* WK = (bf16_t*)(p.ws + OFF_WK); bf16_t* QK = (bf16_t*)(p.ws + OFF_QK);
    float* GE = (float*)(p.ws + OFF_GE);
    const int h = blockIdx.x & 15, bstep = gridDim.x >> 4;
    for (int i = tid; i < 1536; i += 512) { const int j = i / 384, r = i - j * 384, which = r >> 7, c = r & 127; scw[i] = p.dn_conv_w[(size_t)j * 6144 + which * 2048 + h * 128 + c]; }
    const float alog = -__expf(p.dn_a_log[h]), dtb = p.dn_dt_bias[h];
    u32x4 pre[7]; float pgb = 0.f, pga = 0.f;
#define P2_LOAD(bcc) do { const int bc_ = (bcc), c_ = bc_ & 31, t0_ = bc_ * 64; \
        _Pragma("unroll") for (int i = 0; i < 7; ++i) { const int idx = tid + 512 * i; u32x4 v = {0u, 0u, 0u, 0u}; \
            if (idx < 67 * 48) { const int r = idx / 48, pc = idx - r * 48, seg = pc >> 4, c8 = (pc & 15) * 8, colg = seg * 2048 + h * 128 + c8; \
                if (r >= 3) v = *(const u32x4*)(DNQKV + (size_t)(t0_ + r - 3) * 6144 + colg); \
                else if (c_ > 0) v = *(const u32x4*)(HALO + ((size_t)(bc_ - 1) * 3 + r) * 6144 + colg); } \
            pre[i] = v; } \
        if (wid == 0) { pgb = GATES[(size_t)(t0_ + lane) * 64 + 16 + h]; pga = GATES[(size_t)(t0_ + lane) * 64 + 32 + h]; } } while (0)
    int bc = blockIdx.x >> 4;
    if (p.flags & 32) bc = 256;
    if (bc < 256) P2_LOAD(bc);
#pragma unroll 1
    for (; bc < 256; bc += bstep) {
        const int t0 = bc * 64; const int item = bc * 16 + h;
#pragma unroll
        for (int i = 0; i < 7; ++i) { const int idx = tid + 512 * i; if (idx < 67 * 48) { const int r = idx / 48, pc = idx - r * 48, seg = pc >> 4, c8 = (pc & 15) * 8; *(u32x4*)(sraw + r * 392 + seg * 128 + c8) = pre[i]; } }
        if (wid == 0) { const float beta = fast_sigmoid(pgb); const float xs = pga + dtb; const float g = alog * (fmaxf(xs, 0.f) + flog1pexp_negabs(xs));
            const float gam = dpp_incl_sum(g); sbeta[lane] = beta; sgam[lane] = gam; sbg[lane] = beta * fexp(gam);
            if (lane == 63) GE[item] = fexp(gam); }
        lds_bar();
        if (bc + bstep < 256) P2_LOAD(bc + bstep);
        if (!(p.flags & 2))
#pragma unroll 3
        for (int it = 0; it < 6; ++it) { const int idx = it * 512 + tid, cg16 = idx & 15, st = idx >> 4, which = st >> 6, t = st & 63, col = which * 128 + cg16 * 8;
            float y[8];
#pragma unroll
            for (int e = 0; e < 8; ++e) y[e] = 0.f;
#pragma unroll
            for (int j = 0; j < 4; ++j) { const u32x4 rv = *(const u32x4*)(sraw + (t + j) * 392 + col); float xv[8]; unpack8(rv, xv);
                const f32x4 w0 = *(const f32x4*)(scw + j * 384 + col), w1 = *(const f32x4*)(scw + j * 384 + col + 4);
#pragma unroll
                for (int e = 0; e < 4; ++e) { y[e] += w0[e] * xv[e]; y[4 + e] += w1[e] * xv[4 + e]; } }
            float ss = 0.f;
#pragma unroll
            for (int e = 0; e < 8; ++e) { y[e] = y[e] * fast_sigmoid(y[e]); ss += y[e] * y[e]; }
            ss = row16_sum(ss);
            const float scale = which == 2 ? 1.f : rsqrtf(ss + EPS) * (which == 0 ? 0.08838834764831845f : 1.f);
#pragma unroll
            for (int e = 0; e < 8; ++e) y[e] *= scale;
            bf16_t* dst = (which == 0 ? sqn : (which == 1 ? skn : svn)) + t * 136 + cg16 * 8;
            *(u32x4*)dst = pack8(y); }
        lds_bar();
        if (!(p.flags & 4)) { const int tr = wid >> 1, tcb = (wid & 1) * 2;
#pragma unroll
            for (int ti = 0; ti < 2; ++ti) { const int tc = tcb + ti; f32x4 akk = {0.f, 0.f, 0.f, 0.f}, aqk = {0.f, 0.f, 0.f, 0.f};
                if (tc <= tr) { mma16<4>(akk, skn, 136, tr * 16, skn, 136, tc * 16, lane); mma16<4>(aqk, sqn, 136, tr * 16, skn, 136, tc * 16, lane); }
                f32x4 av;
#pragma unroll
                for (int reg = 0; reg < 4; ++reg) { const int t = tr * 16 + q * 4 + reg, s = tc * 16 + cl; const float dec = (s <= t) ? fexp(sgam[t] - sgam[s]) : 0.f;
                    av[reg] = (s < t) ? sbeta[t] * akk[reg] * dec : 0.f;
                    QK[(size_t)(t0 + t) * 1024 + h * 64 + s] = f2bf(aqk[reg] * dec); }
                *(f32x4*)(sA + (tc * 16 + cl) * 80 + tr * 16 + q * 4) = av; } }
        { const float glast = sgam[63];
#pragma unroll
            for (int it = 0; it < 2; ++it) { const int rem = it * 512 + tid, t = rem >> 4, c8 = (rem & 15) * 8;
                const float sc = fexp(sgam[t]);
                float f[8]; unpack8(*(const u32x4*)(sqn + t * 136 + c8), f);
#pragma unroll
                for (int e = 0; e < 8; ++e) f[e] *= sc;
                *(u32x4*)(DNQKV + (size_t)(t0 + t) * 6144 + h * 128 + c8) = pack8(f); }
            { const int t = lane; const float sc = fexp(glast - sgam[t]);
#pragma unroll
                for (int i = 0; i < 2; ++i) { const int d8 = (wid * 2 + i) * 8; float f[8]; unpack8(*(const u32x4*)(skn + t * 136 + d8), f);
#pragma unroll
                    for (int e = 0; e < 8; ++e) { const int dk = d8 + e; DNQKV[(size_t)(t0 + (dk >> 1)) * 6144 + 2048 + h * 128 + (dk & 1) * 64 + t] = f2bf(f[e] * sc); } } } }
        lds_bar();
        if (wid < 4 && !(p.flags & 8)) { const int I = wid, j = lane & 15; float x[16];
            const f32x4 av = *(const f32x4*)(sA + (16 * I + (lane >> 2)) * 80 + 16 * I + (lane & 3) * 4);
#pragma unroll
            for (int i = 0; i < 16; ++i) x[i] = (i == j) ? 1.f : 0.f;
#pragma unroll
            for (int k = 0; k < 15; ++k) { const float xk = x[k];
#pragma unroll
                for (int i = k + 1; i < 16; ++i) { const float ae = av[i & 3]; const float a = __int_as_float(__builtin_amdgcn_readlane(__float_as_int(ae), k * 4 + (i >> 2))); x[i] -= a * xk; } }
            if (lane < 16) {
#pragma unroll
                for (int i = 0; i < 16; ++i) sT[I * 272 + i * 17 + j] = x[i]; } }
        if (wid >= 4) {
#pragma unroll
        for (int it = 0; it < 8; ++it) { const int idx = it * 256 + (tid - 256), which = idx >> 10, rem = idx & 1023, t = rem >> 4, c8 = (rem & 15) * 8;
            const float sc = which == 0 ? sbeta[t] : sbg[t];
            float f[8]; unpack8(*(const u32x4*)((which == 0 ? svn : skn) + t * 136 + c8), f);
            f32x4 o0, o1;
#pragma unroll
            for (int e = 0; e < 4; ++e) { o0[e] = f[e] * sc; o1[e] = f[4 + e] * sc; }
            float* d = sR + t * 272 + which * 128 + c8; *(f32x4*)d = o0; *(f32x4*)(d + 4) = o1; } }
        lds_bar();
        if (!(p.flags & 1)) {
            const int c0a = wid * 32 + cl, c0b = c0a + 16;
#pragma unroll
            for (int I = 0; I < 4; ++I) {
                if (I > 0) {
                    f32x4 acc0, acc1; float af[12], b0[12], b1[12];
#pragma unroll
                    for (int reg = 0; reg < 4; ++reg) { acc0[reg] = sR[(16 * I + q * 4 + reg) * 272 + c0a]; acc1[reg] = sR[(16 * I + q * 4 + reg) * 272 + c0b]; }
#pragma unroll
                    for (int kk = 0; kk < 4 * I; ++kk) { af[kk] = -sA[(4 * kk + q) * 80 + 16 * I + cl]; b0[kk] = sR[(4 * kk + q) * 272 + c0a]; b1[kk] = sR[(4 * kk + q) * 272 + c0b]; }
#pragma unroll
                    for (int kk = 0; kk < 4 * I; ++kk) { acc0 = __builtin_amdgcn_mfma_f32_16x16x4f32(af[kk], b0[kk], acc0, 0, 0, 0); acc1 = __builtin_amdgcn_mfma_f32_16x16x4f32(af[kk], b1[kk], acc1, 0, 0, 0); }
#pragma unroll
                    for (int reg = 0; reg < 4; ++reg) { sR[(16 * I + q * 4 + reg) * 272 + c0a] = acc0[reg]; sR[(16 * I + q * 4 + reg) * 272 + c0b] = acc1[reg]; }
                }
                { float ta[4], d0[4], d1[4]; f32x4 x0 = {0.f, 0.f, 0.f, 0.f}, x1 = {0.f, 0.f, 0.f, 0.f};
#pragma unroll
                    for (int kk = 0; kk < 4; ++kk) { ta[kk] = sT[I * 272 + cl * 17 + 4 * kk + q]; d0[kk] = sR[(16 * I + 4 * kk + q) * 272 + c0a]; d1[kk] = sR[(16 * I + 4 * kk + q) * 272 + c0b]; }
#pragma unroll
                    for (int kk = 0; kk < 4; ++kk) { x0 = __builtin_amdgcn_mfma_f32_16x16x4f32(ta[kk], d0[kk], x0, 0, 0, 0); x1 = __builtin_amdgcn_mfma_f32_16x16x4f32(ta[kk], d1[kk], x1, 0, 0, 0); }
#pragma unroll
                    for (int reg = 0; reg < 4; ++reg) { sR[(16 * I + q * 4 + reg) * 272 + c0a] = x0[reg]; sR[(16 * I + q * 4 + reg) * 272 + c0b] = x1[reg]; }
                }
            }
        }
        lds_bar();
#pragma unroll
        for (int it = 0; it < 4; ++it) { const int idx = it * 512 + tid, which = idx >> 10, rem = idx & 1023, t = rem >> 4, c8 = (rem & 15) * 8;
            const float* d = sR + t * 272 + which * 128 + c8; const f32x4 o0 = *(const f32x4*)d, o1 = *(const f32x4*)(d + 4);
            u32x4 w; w.x = pk(o0[0], o0[1]); w.y = pk(o0[2], o0[3]); w.z = pk(o1[0], o1[1]); w.w = pk(o1[2], o1[3]);
            if (which == 0) *(u32x4*)(DNQKV + (size_t)(t0 + t) * 6144 + 4096 + h * 128 + c8) = w;
            else *(u32x4*)(WK + (size_t)(t0 + t) * 2048 + h * 128 + c8) = w; }
        lds_bar();
    }
#undef P2_LOAD
}

DI void scan_dn(const Params& p, unsigned char* lds, int item) {
    const int tid = threadIdx.x, lane = tid & 63, wid = tid >> 6, q = lane >> 4, cl = lane & 15;
    const int b = item >> 4, h = item & 15;
    bf16_t* swk = (bf16_t*)lds;
    bf16_t* sqd = swk + 64 * 136;
    bf16_t* swv = sqd + 64 * 136;
    bf16_t* sqk = swv + 64 * 136;
    bf16_t* skeT = sqk + 64 * 72;
    bf16_t* suT = skeT + 128 * 72;
    bf16_t* sSt = suT + 128 * 72;
    bf16_t* ssz = sSt + 128 * 136;
    float* sssq = (float*)(ssz + 64 * 136);
    bf16_t* SDZ = (bf16_t*)(p.ws + OFF_SDZ);
    bf16_t* DNQKV = (bf16_t*)(p.ws + OFF_DNQKV); const bf16_t* WK = (const bf16_t*)(p.ws + OFF_WK); const bf16_t* QK = (const bf16_t*)(p.ws + OFF_QK);
    const float* GE = (const float*)(p.ws + OFF_GE);
    for (int i = tid; i < 128 * 136 / 2; i += 512) ((unsigned*)sSt)[i] = 0u;
    f32x4 accS[8];
#pragma unroll
    for (int i = 0; i < 8; ++i) accS[i] = (f32x4){0.f, 0.f, 0.f, 0.f};
    bf16_t* oout = SDZ + (size_t)b * 2048 * 2048 + h * 128;
    u32x4 rwk[2], rqd[2], rke[2], rwv[2], rsz[2], rqk; float ge;
    f32x4 nw[4];
#pragma unroll
    for (int j = 0; j < 4; ++j) nw[j] = *(const f32x4*)(p.dn_norm_w + ((wid >> 2) * 4 + j) * 16 + q * 4);
#define DN_LOAD(cc) do { const size_t tb = (size_t)b * 2048 + (size_t)(cc) * 64; \
        _Pragma("unroll") for (int i = 0; i < 2; ++i) { const int piece = tid + 512 * i, t = piece >> 4, c8 = (piece & 15) * 8; const size_t ro = (tb + t) * 6144 + h * 128 + c8; \
            rwk[i] = *(const u32x4*)(WK + (tb + t) * 2048 + h * 128 + c8); rqd[i] = *(const u32x4*)(DNQKV + ro); rke[i] = *(const u32x4*)(DNQKV + ro + 2048); rwv[i] = *(const u32x4*)(DNQKV + ro + 4096); rsz[i] = *(const u32x4*)(SDZ + (tb + t) * 2048 + h * 128 + c8); } \
        rqk = *(const u32x4*)(QK + (tb + (tid >> 3)) * 1024 + h * 64 + (tid & 7) * 8); \
        ge = GE[((size_t)(b * 32 + (cc))) * 16 + h]; } while (0)
    DN_LOAD(0);
    lds_bar();
#pragma unroll 1
    for (int c = 0; c < 32; ++c) {
        const size_t t0 = (size_t)b * 2048 + (size_t)c * 64;
#pragma unroll
        for (int i = 0; i < 2; ++i) { const int piece = tid + 512 * i, t = piece >> 4, c8 = (piece & 15) * 8;
            *(u32x4*)(swk + t * 136 + c8) = rwk[i]; *(u32x4*)(sqd + t * 136 + c8) = rqd[i]; *(u32x4*)(swv + t * 136 + c8) = rwv[i]; *(u32x4*)(ssz + t * 136 + c8) = rsz[i];
            *(u32x4*)(skeT + (2 * t + (c8 >> 6)) * 72 + (c8 & 63)) = rke[i]; }
        *(u32x4*)(sqk + (tid >> 3) * 72 + (tid & 7) * 8) = rqk;
        const float gec = ge;
        if (c + 1 < 32) DN_LOAD(c + 1);
        lds_bar();
        const int tr = wid & 3, hb = (wid >> 2) * 4;
        bf16x8 afk[4]; lda16<4>(afk, swk, 136, tr * 16, lane);
#pragma unroll
        for (int j = 0; j < 4; ++j) { const int nt = hb + j; f32x4 a = {0.f, 0.f, 0.f, 0.f};
            mma16r<4>(a, afk, sSt, 136, nt * 16, lane);
            const int dv = nt * 16 + cl, tq = tr * 16 + q * 4;
            const float u0 = bf2f(swv[(tq + 0) * 136 + dv]) - a[0], u1 = bf2f(swv[(tq + 1) * 136 + dv]) - a[1], u2 = bf2f(swv[(tq + 2) * 136 + dv]) - a[2], u3 = bf2f(swv[(tq + 3) * 136 + dv]) - a[3];
            u32x2 w; w.x = pk(u0, u1); w.y = pk(u2, u3); *(u32x2*)(suT + dv * 72 + tq) = w; }
        lds_bar();
        bf16x8 afq[4], afs[2]; lda16<4>(afq, sqd, 136, tr * 16, lane); lda16<2>(afs, sqk, 72, tr * 16, lane);
        f32x4 ao[4]; float psq = 0.f;
        const int to = tr * 16 + cl;
#pragma unroll
        for (int j = 0; j < 4; ++j) { const int nt = hb + j; ao[j] = (f32x4){0.f, 0.f, 0.f, 0.f};
            mma16rT<4>(ao[j], afq, sSt, 136, nt * 16, lane);
            mma16rT<2>(ao[j], afs, suT, 72, nt * 16, lane);
            psq += ao[j][0] * ao[j][0] + ao[j][1] * ao[j][1] + ao[j][2] * ao[j][2] + ao[j][3] * ao[j][3];
            const u32x2 zz = *(const u32x2*)(ssz + to * 136 + nt * 16 + q * 4);
            ao[j][0] *= nw[j][0] * bflo(zz.x); ao[j][1] *= nw[j][1] * bfhi(zz.x); ao[j][2] *= nw[j][2] * bflo(zz.y); ao[j][3] *= nw[j][3] * bfhi(zz.y); }
        psq += __shfl_xor(psq, 16); psq += __shfl_xor(psq, 32);
        if (q == 0) sssq[(wid >> 2) * 64 + to] = psq;
        bf16x8 afe[2]; lda16<2>(afe, skeT, 72, wid * 16, lane);
#pragma unroll
        for (int nt = 0; nt < 8; ++nt) { accS[nt] *= gec; mma16r<2>(accS[nt], afe, suT, 72, nt * 16, lane); if (nt & 1) asm volatile("" ::: "memory"); }
        lds_bar();
#pragma unroll
        for (int nt = 0; nt < 8; ++nt) { const int dv = nt * 16 + cl, dk0 = wid * 16 + q * 4; u32x2 w; w.x = pk(accS[nt][0], accS[nt][1]); w.y = pk(accS[nt][2], accS[nt][3]); *(u32x2*)(sSt + dv * 136 + dk0) = w; }
        { const float rs = rsqrtf((sssq[to] + sssq[64 + to]) * (1.f / 128.f) + EPS);
#pragma unroll
            for (int j = 0; j < 4; ++j) { u32x2 w; w.x = pk(ao[j][0] * rs, ao[j][1] * rs); w.y = pk(ao[j][2] * rs, ao[j][3] * rs);
                *(u32x2*)(oout + (unsigned)((c * 64 + to) * 2048 + (hb + j) * 16 + q * 4)) = w; } }
    }
#undef DN_LOAD
    lds_bar();
}

DI void scan_ml(const Params& p, unsigned char* lds, int item) {
    const int tid = threadIdx.x, lane = tid & 63, wid = tid >> 6, q = lane >> 4, cl = lane & 15;
    const int b = item >> 4, h = (item >> 1) & 7, sl = item & 1, vcol = h * 256 + sl * 128;
    bf16_t* sq = (bf16_t*)lds;
    bf16_t* sk = sq + 64 * 136;
    bf16_t* sCt = sk + 64 * 136;
    bf16_t* skwT = sCt + 144 * 136;
    bf16_t* sVt = skwT + 128 * 72;
    bf16_t* sP = sVt + 144 * 72;
    float* sf = (float*)(sP + 64 * 72);
    float *s_bcum = sf, *s_a = sf + 64, *s_mt = sf + 128, *s_iw = sf + 192, *s_emt = sf + 256, *s_ew = sf + 320, *s_sc = sf + 384;
    bf16_t* sv = (bf16_t*)(lds + 124416);
    const bf16_t* MLQ = (const bf16_t*)(p.ws + OFF_MLQ); const bf16_t* MLK = (const bf16_t*)(p.ws + OFF_MLK); bf16_t* MLV = (bf16_t*)(p.ws + OFF_MLV);
    const float* GATES = (const float*)(p.ws + OFF_GATES);
    for (int i = tid; i < 144 * 136 / 2; i += 512) ((unsigned*)sCt)[i] = 0u;
    for (int i = tid; i < 16 * 72; i += 512) sVt[128 * 72 + i] = (i < 72) ? (bf16_t)0x3F80u : (bf16_t)0u;
    f32x4 accC[9];
#pragma unroll
    for (int i = 0; i < 9; ++i) accC[i] = (f32x4){0.f, 0.f, 0.f, 0.f};
    const float ibias = p.ml_i_bias[h], fbias = p.ml_f_bias[h];
    bf16_t* hout = MLV + (size_t)b * 2048 * 2048 + vcol;
    float m_run = 0.f;
    u32x4 rq[2], rk[2], rv[2]; float gi = 0.f, gf = 0.f;
#define ML_LOAD(cc) do { const size_t tb = (size_t)b * 2048 + (size_t)(cc) * 64; \
        _Pragma("unroll") for (int i = 0; i < 2; ++i) { const int piece = tid + 512 * i, t = piece >> 4, c8 = (piece & 15) * 8; \
            rq[i] = *(const u32x4*)(MLQ + (tb + t) * 1024 + h * 128 + c8); rk[i] = *(const u32x4*)(MLK + (tb + t) * 1024 + h * 128 + c8); rv[i] = *(const u32x4*)(MLV + (tb + t) * 2048 + vcol + c8); } \
        if (wid == 0) { gi = GATES[(tb + lane) * 64 + h]; gf = GATES[(tb + lane) * 64 + 8 + h]; } } while (0)
    ML_LOAD(0);
    lds_bar();
#pragma unroll 1
    for (int c = 0; c < 32; ++c) {
        const size_t t0 = (size_t)b * 2048 + (size_t)c * 64;
#pragma unroll
        for (int i = 0; i < 2; ++i) { const int piece = tid + 512 * i, t = piece >> 4, c8 = (piece & 15) * 8;
            *(u32x4*)(sq + t * 136 + c8) = rq[i]; *(u32x4*)(sk + t * 136 + c8) = rk[i]; *(u32x4*)(sv + t * 136 + c8) = rv[i]; }
        if (wid == 0) {
            const float ipre = fsoftcap(gi + ibias); const float fc = fsoftcap(gf + fbias); const float lf = fminf(fc, 0.f) - flog1pexp_negabs(fc);
            const float bcum = dpp_incl_sum(lf); const float a = ipre - bcum; const float pm = dpp_incl_max(a);
            const float bl = __int_as_float(__builtin_amdgcn_readlane(__float_as_int(bcum), 63)), pml = __int_as_float(__builtin_amdgcn_readlane(__float_as_int(pm), 63));
            const float il = bcum + m_run, mt = fmaxf(il, bcum + pm);
            const float mnew = fmaxf(bl + m_run, bl + pml);
            s_bcum[lane] = bcum; s_a[lane] = a; s_mt[lane] = mt; s_iw[lane] = fexp(il - mt); s_emt[lane] = fexp(-mt); s_ew[lane] = fexp(bl + a - mnew);
            if (lane == 0) s_sc[0] = fexp(bl + m_run - mnew);
            m_run = mnew;
        }
        if (c + 1 < 32) ML_LOAD(c + 1);
        lds_bar();
#pragma unroll
        for (int i = 0; i < 2; ++i) { const int t = lane, d8 = (wid * 2 + i) * 8; float f[8]; unpack8(*(const u32x4*)(sk + t * 136 + d8), f); const float ew = s_ew[t];
#pragma unroll
            for (int e = 0; e < 8; ++e) skwT[(d8 + e) * 72 + t] = f2bf(f[e] * ew); }
        asm volatile("" ::: "memory");
#pragma unroll
        for (int i = 0; i < 2; ++i) { const int t = lane, d8 = (wid * 2 + i) * 8; const u32x4 vv = *(const u32x4*)(sv + t * 136 + d8);
#pragma unroll
            for (int e = 0; e < 8; ++e) sVt[(d8 + e) * 72 + t] = (bf16_t)((vv[e >> 1] >> ((e & 1) * 16)) & 0xffffu); }
        asm volatile("" ::: "memory");
        { const int tr = wid >> 1, tcb = (wid & 1) * 2;
            bf16x8 afq[4]; lda16<4>(afq, sq, 136, tr * 16, lane);
#pragma unroll
            for (int ti = 0; ti < 2; ++ti) { const int tc = tcb + ti; f32x4 a = {0.f, 0.f, 0.f, 0.f};
                if (tc <= tr) mma16r<4>(a, afq, sk, 136, tc * 16, lane);
#pragma unroll
                for (int reg = 0; reg < 4; ++reg) { const int t = tr * 16 + q * 4 + reg, s = tc * 16 + cl;
                    const float w = (s <= t) ? fexp(s_bcum[t] + s_a[s] - s_mt[t]) * a[reg] : 0.f;
                    sP[t * 72 + s] = f2bf(w); } } }
        lds_bar();
        { const int tr = wid & 3, hb = (wid >> 2) * 4, tq = tr * 16 + q * 4;
            f32x4 an[5];
#pragma unroll
            for (int j = 0; j < 5; ++j) { const int nt = j < 4 ? hb + j : 8; an[j] = (f32x4){0.f, 0.f, 0.f, 0.f}; mma16<4>(an[j], sq, 136, tr * 16, sCt, 136, nt * 16, lane); asm volatile("" ::: "memory"); }
            bf16x8 afp[2]; lda16<2>(afp, sP, 72, tr * 16, lane);
            f32x4 iw; iw[0] = s_iw[tq]; iw[1] = s_iw[tq + 1]; iw[2] = s_iw[tq + 2]; iw[3] = s_iw[tq + 3];
#pragma unroll
            for (int j = 0; j < 5; ++j) { const int nt = j < 4 ? hb + j : 8; an[j] *= iw; mma16r<2>(an[j], afp, sVt, 72, nt * 16, lane); }
            float rden[4];
#pragma unroll
            for (int reg = 0; reg < 4; ++reg) { const float den = __shfl(an[4][reg], lane & 48); rden[reg] = __builtin_amdgcn_rcpf(fmaxf(fabsf(den), s_emt[tq + reg])); }
#pragma unroll
            for (int j = 0; j < 4; ++j) { const int dv = (hb + j) * 16 + cl;
#pragma unroll
                for (int reg = 0; reg < 4; ++reg) hout[(unsigned)((c * 64 + tq + reg) * 2048 + dv)] = f2bf(an[j][reg] * rden[reg]); }
            const float decay = s_sc[0];
            bf16x8 afw[2]; lda16<2>(afw, skwT, 72, wid * 16, lane);
#pragma unroll
            for (int nt = 0; nt < 9; ++nt) { accC[nt] *= decay; mma16r<2>(accC[nt], afw, sVt, 72, nt * 16, lane); if (nt & 1) asm volatile("" ::: "memory"); }
        }
        lds_bar();
#pragma unroll
        for (int nt = 0; nt < 9; ++nt) { const int dv = nt * 16 + cl, dk0 = wid * 16 + q * 4; u32x2 w; w.x = pk(accC[nt][0], accC[nt][1]); w.y = pk(accC[nt][2], accC[nt][3]); *(u32x2*)(sCt + dv * 136 + dk0) = w; }
    }
#undef ML_LOAD
    lds_bar();
}

DI void p4_normgate(const Params& p) {
    const int tid = threadIdx.x, lane = tid & 63, wid = tid >> 6;
    bf16_t* MLV = (bf16_t*)(p.ws + OFF_MLV); const bf16_t* OZ = (const bf16_t*)(p.ws + OFF_OZ);
    const int rstep = gridDim.x * 8;
#pragma unroll 1
    for (int tok = blockIdx.x * 8 + wid; tok < T_TOK; tok += 2 * rstep) {
        const int tok2 = (tok + rstep < T_TOK) ? tok + rstep : tok;
        u32x4 ha[4], ga[4], hb2[4], gb2[4];
#pragma unroll
        for (int it = 0; it < 4; ++it) { const int c0 = it * 512 + lane * 8;
            ha[it] = *(const u32x4*)(MLV + (size_t)tok * 2048 + c0); ga[it] = *(const u32x4*)(OZ + (size_t)tok * 2048 + c0);
            hb2[it] = *(const u32x4*)(MLV + (size_t)tok2 * 2048 + c0); gb2[it] = *(const u32x4*)(OZ + (size_t)tok2 * 2048 + c0); }
#pragma unroll
        for (int it = 0; it < 4; ++it) { const int c0 = it * 512 + lane * 8;
            const float4 w0 = *(const float4*)(p.ml_norm_w + c0), w1 = *(const float4*)(p.ml_norm_w + c0 + 4);
            const float w[8] = {w0.x, w0.y, w0.z, w0.w, w1.x, w1.y, w1.z, w1.w};
#pragma unroll
            for (int s2 = 0; s2 < 2; ++s2) { float hv[8], gv[8]; unpack8(s2 ? hb2[it] : ha[it], hv); unpack8(s2 ? gb2[it] : ga[it], gv);
                float ss = 0.f;
#pragma unroll
                for (int e = 0; e < 8; ++e) ss += hv[e] * hv[e];
                ss = row16_sum(ss); ss += __shfl_xor(ss, 16);
                const float rs = rsqrtf(ss * (1.f / 256.f) + EPS);
#pragma unroll
                for (int e = 0; e < 8; ++e) hv[e] = hv[e] * rs * w[e] * gv[e];
                if (s2 == 0 || tok2 != tok) *(u32x4*)(MLV + (size_t)(s2 ? tok2 : tok) * 2048 + c0) = pack8(hv); } }
    }
}

DI void p6_final(const Params& p) {
    const int tid = threadIdx.x, lane = tid & 63, wid = tid >> 6;
    const float* rowss = (const float*)(p.ws + OFF_ROWSS);
    for (int tok = blockIdx.x * 8 + wid; tok < T_TOK; tok += gridDim.x * 8) {
        const float rs = rsqrtf(rowss[tok] * (1.f / 2048.f) + EPS);
        float4* o = (float4*)(p.out + (size_t)tok * 2048);
#pragma unroll
        for (int i = 0; i < 8; ++i) { float4 v = o[i * 64 + lane]; const float4 w = ((const float4*)p.final_norm_w)[i * 64 + lane];
            v.x *= rs * w.x; v.y *= rs * w.y; v.z *= rs * w.z; v.w *= rs * w.w; o[i * 64 + lane] = v; }
    }
}


#ifdef DBG
DI void p7_debug(const Params& p) {
    const bf16_t* MLV = (const bf16_t*)(p.ws + OFF_MLV); const bf16_t* MLQ = (const bf16_t*)(p.ws + OFF_MLQ); const bf16_t* MLK = (const bf16_t*)(p.ws + OFF_MLK);
    const bf16_t* OZ = (const bf16_t*)(p.ws + OFF_OZ); const bf16_t* DNQKV = (const bf16_t*)(p.ws + OFF_DNQKV); const bf16_t* SDZ = (const bf16_t*)(p.ws + OFF_SDZ);
    const float* GATES = (const float*)(p.ws + OFF_GATES); const bf16_t* WK = (const bf16_t*)(p.ws + OFF_WK); const bf16_t* QK = (const bf16_t*)(p.ws + OFF_QK);
    const float* GE = (const float*)(p.ws + OFF_GE); const bf16_t* AB = (const bf16_t*)(p.ws + OFF_MLQ);
    for (size_t i = (size_t)blockIdx.x * 512 + threadIdx.x; i < (size_t)T_TOK * 2048; i += (size_t)gridDim.x * 512) {
        const size_t t = i >> 11; const int c = (int)(i & 2047); float v = 0.f;
#if DBG == 1
        const unsigned pr = ((const unsigned*)p.out)[i];
        v = bf2f(MLV[t * 2048 + c]) + bf2f(OZ[t * 2048 + c]) + bf2f(SDZ[t * 2048 + c]) + bf2f(DNQKV[t * 6144 + c]) + bf2f(DNQKV[t * 6144 + 2048 + c]) + bf2f(DNQKV[t * 6144 + 4096 + c])
          + bf2f(MLQ[t * 1024 + (c & 1023)]) + bf2f(MLK[t * 1024 + (c & 1023)]) + GATES[t * 64 + (c & 63)] + bflo(pr) + bfhi(pr);
#elif DBG == 2
        v = bf2f(DNQKV[t * 6144 + c]) + bf2f(DNQKV[t * 6144 + 2048 + c]) + bf2f(DNQKV[t * 6144 + 4096 + c]) + bf2f(WK[t * 2048 + c]) + bf2f(QK[t * 1024 + (c & 1023)]) + GE[(t >> 6) * 16 + (c & 15)];
#elif DBG == 3
        v = bf2f(MLV[t * 2048 + c]) + bf2f(DNQKV[t * 6144 + 4096 + c]);
#elif DBG == 4
        v = bf2f(MLV[t * 2048 + c]) + bf2f(AB[t * 2048 + c]);
#elif DBG == 5
        v = bf2f(MLV[t * 2048 + c]);
#elif DBG == 6
        v = bf2f(DNQKV[t * 6144 + 4096 + c]);
#endif
        p.out[i] = v;
    }
}
#endif
__global__ void __launch_bounds__(512) hybrid_fwd(Params p) {
    extern __shared__ __attribute__((aligned(16))) unsigned char lds[];
    cg::grid_group grid = cg::this_grid();
    const int lo = p.ph_lo, hi = p.ph_hi;
    volatile LAS unsigned* xst = (volatile LAS unsigned*)((LAS unsigned char*)lds + (LDS_BYTES - 16));
    if (threadIdx.x < 4) xst[threadIdx.x] = 0u;
    __syncthreads();
    XcdBarrier xbar; xbar.bar = (unsigned*)(p.ws + OFF_BAR); xbar.x = 0; xbar.st = xst;
    if (hi - lo > 1) xbar = xcd_barrier_post((unsigned*)(p.ws + OFF_BAR), xst);
#ifndef PH_MASK
#define PH_MASK 127
#endif
#define IN(k) (((PH_MASK >> (k)) & 1) && lo <= (k) && (k) < hi)
#define SEAM(k) do { if (IN(k) && IN((k) + 1)) { if (p.flags == 0x40000000) grid.sync(); else xcd_barrier(xbar); } } while (0)
    if (IN(0)) p0_prologue(p, lds);
    SEAM(0);
    if (IN(1)) {
        pg8::Gemm g{(const pg8::bf16_t*)(p.ws + OFF_U), (const pg8::bf16_t*)(p.ws + OFF_WT), T_TOK, NPAD, 2048};
        pg8::StaticOrder S; S.init(T_TOK, NPAD, (int)gridDim.x, (int)blockIdx.x);
        EpiProj E{p.ws, (unsigned*)p.out, p.flags};
        pg8::gemm_phase<EpiProj, pg8::StaticOrder>((PG8_LAS unsigned char*)lds, g, S, E, nullptr);
    }
    SEAM(1);
    if (IN(2)) p2_dnprep(p, lds);
    SEAM(2);
    if (IN(3)) {
#ifndef NO_DN
        if (!(p.flags & 64)) for (int item = blockIdx.x; item < 256; item += gridDim.x) if (item < 128) scan_dn(p, lds, item);
#endif
#ifndef NO_ML
        if (!(p.flags & 128)) for (int item = blockIdx.x; item < 256; item += gridDim.x) if (item >= 128) scan_ml(p, lds, item - 128);
        { const int nml = gridDim.x > 128 ? (int)gridDim.x - 128 : (int)gridDim.x, fml = gridDim.x > 128 ? (int)blockIdx.x - 128 : (int)blockIdx.x;
          if (fml >= 0) p0_transpose(p, lds, (NPAD / 256) * 32, (NPAD / 256) * 32 + 2 * 8 * 32, fml, nml); }
#endif
    }
    SEAM(3);
    if (IN(4)) p4_normgate(p);
    SEAM(4);
    if (IN(5)) {
        pg8::Gemm g{(const pg8::bf16_t*)(p.ws + OFF_MLV), (const pg8::bf16_t*)(p.ws + OFF_WOT), 2 * T_TOK, 4096, 2048};
        OutOrder S; S.so.init(T_TOK, 2048, (int)gridDim.x, (int)blockIdx.x);
        EpiOut E{p.x, p.out, (float*)(p.ws + OFF_ROWSS)};
        pg8::gemm_phase<EpiOut, OutOrder>((PG8_LAS unsigned char*)lds, g, S, E, nullptr);
    }
    SEAM(5);
    if (IN(6)) p6_final(p);
#ifdef EXTRA_SYNCS
    if (hi == 7) { for (int i = 0; i < EXTRA_SYNCS; ++i) grid.sync(); }
#endif
#ifdef DBG
    if (p.ph_lo == 7) p7_debug(p);
#endif
#undef IN
#undef SEAM
}

#ifndef N_LAUNCHES
#define N_LAUNCHES 7
#endif
extern "C" void kernel_launch(void* const* d_in, const int* in_sizes, int n_in, void* d_out, int out_size, void* d_ws, size_t ws_size, hipStream_t stream) {
    static int grid = 0;
    if (grid == 0) {
        if (n_in != 12 || out_size != T_TOK * DM || ws_size < WS_END) { fprintf(stderr, "kernel_launch: bad shapes / workspace (%zu < %zu)\n", ws_size, (size_t)WS_END); grid = -1; return; }
        int dev = 0, cus = 0, per_cu = 0;
        hipGetDevice(&dev); hipDeviceGetAttribute(&cus, hipDeviceAttributeMultiprocessorCount, dev);
        if (hipFuncSetAttribute((const void*)hybrid_fwd, hipFuncAttributeMaxDynamicSharedMemorySize, LDS_BYTES) != hipSuccess) { fprintf(stderr, "hipFuncSetAttribute failed\n"); grid = -1; return; }
        if (hipOccupancyMaxActiveBlocksPerMultiprocessor(&per_cu, (const void*)hybrid_fwd, 512, LDS_BYTES) != hipSuccess || per_cu < 1) { fprintf(stderr, "occupancy query: %d\n", per_cu); per_cu = 1; }
        (void)hipGetLastError();
        grid = cus * 1;
    }
    if (grid < 0) return;
    Params p{};
    p.x = (const float*)d_in[0]; p.norm_w = (const float*)d_in[1]; p.w_in = (const float*)d_in[2]; p.ml_i_bias = (const float*)d_in[3]; p.ml_f_bias = (const float*)d_in[4];
    p.ml_norm_w = (const float*)d_in[5]; p.dn_conv_w = (const float*)d_in[6]; p.dn_a_log = (const float*)d_in[7]; p.dn_dt_bias = (const float*)d_in[8]; p.dn_norm_w = (const float*)d_in[9];
    p.w_out = (const float*)d_in[10]; p.final_norm_w = (const float*)d_in[11]; p.out = (float*)d_out; p.ws = (unsigned char*)d_ws;
#if N_LAUNCHES == 1
    (void)hipMemsetAsync((unsigned char*)d_ws + OFF_BAR, 0, (size_t)XCD_BAR_WORDS * 4, stream);
    void* args[] = {&p};
#ifdef REP_HI
    p.ph_lo = REP_LO; p.ph_hi = REP_HI + 1;
#ifdef REP_FLAGS
    p.flags = REP_FLAGS;
#endif
    (void)hipLaunchCooperativeKernel((const void*)hybrid_fwd, dim3(grid), dim3(512), args, LDS_BYTES, stream);
#endif
#ifdef REP_HI
    (void)hipMemsetAsync((unsigned char*)d_ws + OFF_BAR, 0, (size_t)XCD_BAR_WORDS * 4, stream);
#endif
    p.ph_lo = 0; p.ph_hi = 7; p.flags = 0;
    hipError_t e = hipLaunchCooperativeKernel((const void*)hybrid_fwd, dim3(grid), dim3(512), args, LDS_BYTES, stream);
    if (e != hipSuccess) fprintf(stderr, "cooperative launch failed: %s (grid %d)\n", hipGetErrorString(e), grid);
#else
#ifdef DBG
    const int nph = (DBG == 1) ? 2 : (DBG == 2) ? 3 : (DBG == 4) ? 5 : 4;
    for (int ph = 0; ph < nph; ++ph) { p.ph_lo = ph; p.ph_hi = ph + 1; hipLaunchKernelGGL(hybrid_fwd, dim3(grid), dim3(512), LDS_BYTES, stream, p); }
    p.ph_lo = 7; p.ph_hi = 8; hipLaunchKernelGGL(hybrid_fwd, dim3(grid), dim3(512), LDS_BYTES, stream, p);
#else
    for (int ph = 0; ph < 7; ++ph) { p.ph_lo = ph; p.ph_hi = ph + 1; hipLaunchKernelGGL(hybrid_fwd, dim3(grid), dim3(512), LDS_BYTES, stream, p); }
#endif
#endif
}
```

```cpp
#define N_LAUNCHES 1
#include <hip/hip_runtime.h>
#include <hip/hip_cooperative_groups.h>
#include <cstdio>
namespace cg = cooperative_groups;
#define XB_TMO      128
#define XB_XCNT(j)  (256  + 64 * (j))
#define XB_XSUB(j)  (1280 + 64 * (j))
#define XB_XGEN(j)  (2304 + 64 * (j))
#define XB_TOP      3328
#define XB_TOPGEN   3392
#define XCD_BAR_WORDS 3456
#define XB_SPIN_CAP (1u << 18)
#define LAS __attribute__((address_space(3)))

__device__ __forceinline__ unsigned xb_ld(unsigned* p)              { return __hip_atomic_load(p, __ATOMIC_RELAXED, __HIP_MEMORY_SCOPE_AGENT); }
__device__ __forceinline__ unsigned xb_add(unsigned* p, unsigned v) { return __hip_atomic_fetch_add(p, v, __ATOMIC_RELAXED, __HIP_MEMORY_SCOPE_AGENT); }
__device__ __forceinline__ unsigned xb_xcc_id() { return (unsigned)__builtin_amdgcn_s_getreg((3 << 11) | 20) & 0xFu; }
#define XB_SPIN(cond, bar) do { unsigned _sp = 0; while (cond) { __builtin_amdgcn_s_sleep(1); \
    if ((++_sp & 255u) == 0u) { if (xb_ld(&(bar)[XB_TMO])) break; if (_sp > XB_SPIN_CAP) { atomicAdd(&(bar)[XB_TMO], 1u); break; } } } } while (0)

struct XcdBarrier {
    unsigned* bar; unsigned x;
    volatile LAS unsigned* st;
};

__device__ __forceinline__ XcdBarrier xcd_barrier_post(unsigned* bar, volatile LAS unsigned* st) {
    XcdBarrier b; b.bar = bar; b.x = xb_xcc_id(); b.st = st;
    if (threadIdx.x == 0) (void)xb_add(&bar[XB_XCNT(b.x)], 1u);
    return b;
}
__device__ __forceinline__ void xcd_barrier_complete(unsigned* bar, unsigned x, unsigned& nloc, unsigned& nx) {
    const unsigned G = gridDim.x * gridDim.y * gridDim.z;
    unsigned sum, cnt, mine, sp = 0u;
    for (;;) {
        sum = 0u; cnt = 0u; mine = 0u;
#pragma unroll
        for (unsigned j = 0; j < 16; ++j) { const unsigned c = xb_ld(&bar[XB_XCNT(j)]); sum += c; cnt += (c > 0u) ? 1u : 0u; mine = (j == x) ? c : mine; }
        if (sum == G) break;
        __builtin_amdgcn_s_sleep(1);
        if ((++sp & 255u) == 0u) { if (xb_ld(&bar[XB_TMO])) break; if (sp > XB_SPIN_CAP) { atomicAdd(&bar[XB_TMO], 1u); break; } }
    }
    nloc = mine > 0u ? mine : 1u; nx = cnt > 0u ? cnt : 1u;
}

__device__ __forceinline__ void xcd_barrier(const XcdBarrier& b) {
    asm volatile("s_waitcnt vmcnt(0)" ::: "memory");
    __syncthreads();
    if (threadIdx.x == 0) {
        unsigned* bar = b.bar;
        __builtin_amdgcn_s_waitcnt(0);
        unsigned nloc = b.st[0], nx = b.st[1];
        if (nloc == 0u) { xcd_barrier_complete(bar, b.x, nloc, nx); b.st[0] = nloc; b.st[1] = nx; }
        const unsigned old = xb_add(&bar[XB_XSUB(b.x)], 1u);
        const unsigned gen = old / nloc;
        if (old + 1u == (gen + 1u) * nloc) {
            __builtin_amdgcn_fence(__ATOMIC_RELEASE, "agent");
            asm volatile("s_waitcnt vmcnt(0)" ::: "memory");
            const unsigned og = xb_add(&bar[XB_TOP], 1u);
            const unsigned tg = og / nx;
            if (og + 1u == (tg + 1u) * nx) xb_add(&bar[XB_TOPGEN], 1u);
            else XB_SPIN(xb_ld(&bar[XB_TOPGEN]) == tg, bar);
            __builtin_amdgcn_fence(__ATOMIC_ACQUIRE, "agent");
            xb_add(&bar[XB_XGEN(b.x)], 1u);
            asm volatile("s_waitcnt vmcnt(0)" ::: "memory");
        } else {
            XB_SPIN(xb_ld(&bar[XB_XGEN(b.x)]) == gen, bar);
            __builtin_amdgcn_fence(__ATOMIC_ACQUIRE, "agent");
            asm volatile("s_waitcnt vmcnt(0)" ::: "memory");
        }
    }
    __syncthreads();
}
namespace pg8 {
#define PG8_LAS __attribute__((address_space(3)))
typedef unsigned short bf16_t;
typedef short bf16x8 __attribute__((ext_vector_type(8)));
typedef float f32x4 __attribute__((ext_vector_type(4)));
typedef unsigned u32x4 __attribute__((ext_vector_type(4)));
constexpr int BM = 256, BK = 64, HALF = 128, HTB = HALF * BK * 2  , STAGE_BYTES = 8 * HTB, NXCD = 8, WGM = 8;

__host__ __device__ __forceinline__ int lds_byte(int r, int c) { const int st = (r >> 4) * 2 + (c >> 5), rr = r & 15, cc = c & 31, ob = rr * 64 + cc * 2; return st * 1024 + (ob ^ (((ob >> 9) & 1) << 5)); }
__host__ __device__ __forceinline__ void stage_rc(int b, int& R, int& C) { const int st = b / 1024, sb = b % 1024, swz = sb ^ (((sb >> 9) & 1) << 5); R = (st >> 1) * 16 + swz / 64; C = (st & 1) * 32 + (swz % 64) / 2; }
__host__ __device__ __forceinline__ int perm32(int rho) { const int n = rho >> 4, i = rho & 15; return 8 * (i >> 2) + 4 * n + (i & 3); }

struct Unit { int pm, pn; };
struct Gemm { const bf16_t* A; const bf16_t* Bt; int M, N, K; };

struct StaticOrder {
    int nM, nN, nwg, G, c;
    __host__ __device__ void init(int M, int N, int G_, int c_) { nM = M / BM; nN = N / BM; nwg = nM * nN; G = G_; c = c_; }
    __host__ __device__ bool next(int i, Unit& u) const {
        const long L = (long)i * G + c; if (L >= nwg) return false;
        int wgid = (int)L; { const int q = nwg / NXCD, r = nwg % NXCD, xcd = wgid % NXCD, off = wgid / NXCD; wgid = (xcd < r ? xcd * (q + 1) : r * (q + 1) + (xcd - r) * q) + off; }
        const int nig = WGM * nN, gid = wgid / nig, fm = gid * WGM, gsz = (nM - fm) < WGM ? (nM - fm) : WGM;
        u.pm = fm + ((wgid % nig) % gsz); u.pn = (wgid % nig) / gsz; return true;
    }
    __device__ __forceinline__ void a_ready(const Unit&) const {}
    __device__ __forceinline__ void done(const Unit&) const {}
};
__device__ __forceinline__ unsigned cvt_pk_bf16(float lo, float hi) { unsigned r; asm volatile("v_cvt_pk_bf16_f32 %0, %1, %2" : "=v"(r) : "v"(lo), "v"(hi)); return r; }
template <class Epi, class Sched, bool STAMP = false>
__device__ __forceinline__ void gemm_phase(PG8_LAS unsigned char* lds, const Gemm g, const Sched& S, const Epi& E, unsigned long long* stamps) {
    const int tid = threadIdx.x, wid = __builtin_amdgcn_readfirstlane(tid >> 6), lane = tid & 63, wr = wid >> 2, wc = wid & 3, fr = lane & 15, fq = lane >> 4;
    const int K = g.K, nt = K / BK;
    int ts_lo = 0, ts_hi = 0, nts = 0; const unsigned long long rt_entry = STAMP ? (unsigned long long)wall_clock64() : 0ull;
#define PG8_STAMP() do { if (STAMP && wid == 0 && nts < 64) { const unsigned long long _c = (unsigned long long)clock64(); \
        ts_lo = (lane == nts) ? (int)(unsigned)_c : ts_lo; ts_hi = (lane == nts) ? (int)(unsigned)(_c >> 32) : ts_hi; ++nts; } } while (0)
    PG8_STAMP();
    unsigned voffA[2], voffB[2];
#pragma unroll
    for (int i = 0; i < 2; ++i) { int R, C; stage_rc(tid * 16 + i * 8192, R, C); const int Rb = Epi::PERM ? ((R & ~31) + perm32(R & 31)) : R;
        voffA[i] = (unsigned)(R * K + C) * 2u; voffB[i] = (unsigned)(Rb * K + C) * 2u; }
    const size_t kstep = (size_t)(BK * 2);
    const size_t hstep = (size_t)HALF * K * 2;
    const size_t tstep = 2 * hstep;
    const unsigned ldsw = (unsigned)wid * 1024u;
    const int aoff = lds_byte(wr * 64 + fr, fq * 8), boff = lds_byte(wc * 32 + fr, fq * 8);
#define PG8_SA(b, h) (((b) * 2 + (h)) * HTB)
#define PG8_SB(b, h) ((4 + (b) * 2 + (h)) * HTB)
#define PG8_STAGE(bufoff, gbase, voff) do { _Pragma("unroll") for (int _i = 0; _i < 2; ++_i) \
        __builtin_amdgcn_global_load_lds((const unsigned*)((const char*)(gbase) + (voff)[_i]), (PG8_LAS unsigned*)(lds + (bufoff) + ldsw + _i * 8192), 16, 0, 0); } while (0)
#define PG8_LDA(dst, b, h) do { _Pragma("unroll") for (int m = 0; m < 4; ++m) _Pragma("unroll") for (int k = 0; k < 2; ++k) dst[m][k] = *(const PG8_LAS bf16x8*)(lds + PG8_SA(b, h) + aoff + m * 2048 + k * 1024); } while (0)
#define PG8_LDB(dst, b, h) do { _Pragma("unroll") for (int n = 0; n < 2; ++n) _Pragma("unroll") for (int k = 0; k < 2; ++k) dst[n][k] = *(const PG8_LAS bf16x8*)(lds + PG8_SB(b, h) + boff + n * 2048 + k * 1024); } while (0)
#define PG8_MMA(ai, bj, At, Bt) do { __builtin_amdgcn_s_setprio(1); _Pragma("unroll") for (int m = 0; m < 4; ++m) _Pragma("unroll") for (int n = 0; n < 2; ++n) _Pragma("unroll") for (int k = 0; k < 2; ++k) \
        acc[ai][bj][m][n] = __builtin_amdgcn_mfma_f32_16x16x32_bf16(Bt[n][k], At[m][k], acc[ai][bj][m][n], 0, 0, 0); __builtin_amdgcn_s_setprio(0); } while (0)
#define PG8_WAIT_V(n) asm volatile("s_waitcnt vmcnt(" #n ")" ::: "memory")
#define PG8_WAIT_L(n) asm volatile("s_waitcnt lgkmcnt(" #n ")" ::: "memory")
#define PG8_BAR __builtin_amdgcn_s_barrier()
#define PG8_SCHED __builtin_amdgcn_sched_barrier(0)
    Unit cur, nxt; int ui = 0;
    if (!S.next(0, cur)) return;
    f32x4 acc[2][2][4][2];
#pragma unroll
    for (int a = 0; a < 2; ++a)
#pragma unroll
        for (int b = 0; b < 2; ++b)
#pragma unroll
            for (int m = 0; m < 4; ++m)
#pragma unroll
                for (int n = 0; n < 2; ++n) acc[a][b][m][n] = (f32x4){0.f, 0.f, 0.f, 0.f};
    bf16x8 At[4][2], B0[2][2], B1[2][2];
    const char* cA = (const char*)g.A + (size_t)cur.pm * tstep; const char* cB = (const char*)g.Bt + (size_t)cur.pn * tstep;
    S.a_ready(cur);
    PG8_STAGE(PG8_SB(0, 0), cB, voffB); PG8_STAGE(PG8_SA(0, 0), cA, voffA); PG8_STAGE(PG8_SB(0, 1), cB + hstep, voffB); PG8_STAGE(PG8_SA(0, 1), cA + hstep, voffA);
    if (wr == 1) PG8_BAR;
    PG8_WAIT_V(4); PG8_BAR;
    PG8_STAGE(PG8_SB(1, 0), cB + kstep, voffB); PG8_STAGE(PG8_SA(1, 0), cA + kstep, voffA); PG8_STAGE(PG8_SB(1, 1), cB + hstep + kstep, voffB);
    PG8_WAIT_V(6); PG8_BAR;
    PG8_STAMP();
    for (;;) {
        const bool has_next = S.next(ui + 1, nxt);
        const char* nA = has_next ? (const char*)g.A + (size_t)nxt.pm * tstep : cA; const char* nB = has_next ? (const char*)g.Bt + (size_t)nxt.pn * tstep : cB;
        for (int t = 0; t < nt; t += 2) {
            const bool last = (t == nt - 2);
            const char* a1 = cA + (size_t)(t + 1) * kstep;
            const char* a2 = last ? nA : cA + (size_t)(t + 2) * kstep; const char* b2 = last ? nB : cB + (size_t)(t + 2) * kstep;
            const char* a3 = a2 + kstep; const char* b3 = b2 + kstep;
            if (last && has_next) S.a_ready(nxt);
            PG8_LDB(B0, 0, 0); PG8_SCHED; PG8_LDA(At, 0, 0); PG8_STAGE(PG8_SA(1, 1), a1 + hstep, voffA);
            PG8_WAIT_L(8); PG8_BAR; PG8_WAIT_L(0); PG8_MMA(0, 0, At, B0); PG8_BAR; PG8_SCHED;
            PG8_LDB(B1, 0, 1); PG8_STAGE(PG8_SB(0, 0), b2, voffB);
            PG8_BAR; PG8_WAIT_L(0); PG8_MMA(0, 1, At, B1); PG8_BAR;
            PG8_LDA(At, 0, 1); PG8_STAGE(PG8_SA(0, 0), a2, voffA);
            PG8_BAR; PG8_WAIT_L(0); PG8_MMA(1, 0, At, B0); PG8_BAR; PG8_SCHED;
            PG8_STAGE(PG8_SB(0, 1), b2 + hstep, voffB);
            PG8_WAIT_V(6); PG8_BAR; PG8_MMA(1, 1, At, B1); PG8_BAR;
            PG8_LDB(B0, 1, 0); PG8_SCHED; PG8_LDA(At, 1, 0); PG8_STAGE(PG8_SA(0, 1), a2 + hstep, voffA);
            PG8_WAIT_L(8); PG8_BAR; PG8_WAIT_L(0); PG8_MMA(0, 0, At, B0); PG8_BAR; PG8_SCHED;
            PG8_LDB(B1, 1, 1); PG8_STAGE(PG8_SB(1, 0), b3, voffB);
            PG8_BAR; PG8_WAIT_L(0); PG8_MMA(0, 1, At, B1); PG8_BAR;
            PG8_LDA(At, 1, 1); PG8_STAGE(PG8_SA(1, 0), a3, voffA);
            PG8_BAR; PG8_WAIT_L(0); PG8_MMA(1, 0, At, B0); PG8_BAR; PG8_SCHED;
            PG8_STAGE(PG8_SB(1, 1), b3 + hstep, voffB);
            PG8_WAIT_V(6); PG8_BAR; PG8_MMA(1, 1, At, B1); PG8_BAR;
        }
        PG8_STAMP();
        bool keep_acc = false;
        if constexpr (!Epi::AFTER_DRAIN) { keep_acc = E(acc, cur, wr, wc, fr, fq); S.done(cur); }
        PG8_STAMP();
        if (!has_next) break;
        if (!keep_acc)
#pragma unroll
        for (int a = 0; a < 2; ++a)
#pragma unroll
            for (int b = 0; b < 2; ++b)
#pragma unroll
                for (int m = 0; m < 4; ++m)
#pragma unroll
                    for (int n = 0; n < 2; ++n) acc[a][b][m][n] = (f32x4){0.f, 0.f, 0.f, 0.f};
        cur = nxt; cA = nA; cB = nB; ++ui;
    }
    PG8_WAIT_V(0);
    if (wr == 0) PG8_BAR;
    PG8_BAR;
    if constexpr (Epi::AFTER_DRAIN) { E.fused(acc, cur, wr, wc, fr, fq, lds, wid, lane); S.done(cur); }
    PG8_STAMP();
    if (STAMP && wid == 0) { stamps[lane] = lane < nts ? (((unsigned long long)(unsigned)ts_hi << 32) | (unsigned)ts_lo) : 0ull;
        if (lane == 62) stamps[62] = rt_entry; if (lane == 63) stamps[63] = (unsigned long long)wall_clock64(); }
#undef PG8_STAMP
#undef PG8_SA
#undef PG8_SB
#undef PG8_STAGE
#undef PG8_LDA
#undef PG8_LDB
#undef PG8_MMA
#undef PG8_WAIT_V
#undef PG8_WAIT_L
#undef PG8_BAR
#undef PG8_SCHED
}
}

#define DI __device__ __forceinline__
typedef unsigned short bf16_t;
typedef short bf16x8 __attribute__((ext_vector_type(8)));
typedef float f32x4 __attribute__((ext_vector_type(4)));
typedef unsigned u32x4 __attribute__((ext_vector_type(4)));
typedef unsigned u32x2 __attribute__((ext_vector_type(2)));

constexpr int T_TOK = 16384, DM = 2048, IN_DIM = 20528, NPAD = 20736;
constexpr int LDS_BYTES = 152 * 1024;
constexpr float EPS = 1e-6f;

constexpr size_t SZ_T2048 = (size_t)T_TOK * 2048 * 2;
constexpr size_t OFF_WT = 0;
constexpr size_t OFF_QK = 0;
constexpr size_t OFF_U = OFF_WT + (size_t)NPAD * 2048 * 2;
constexpr size_t OFF_WK = OFF_U;
constexpr size_t OFF_MLV = OFF_U + SZ_T2048;
constexpr size_t OFF_MLQ = OFF_MLV + SZ_T2048;
constexpr size_t OFF_MLK = OFF_MLQ + SZ_T2048 / 2;
constexpr size_t OFF_OZ = OFF_MLK + SZ_T2048 / 2;
constexpr size_t OFF_DNQKV = OFF_OZ + SZ_T2048;
constexpr size_t OFF_PBUF = OFF_DNQKV;
constexpr size_t OFF_SDZ = OFF_DNQKV + 3 * SZ_T2048;
constexpr size_t OFF_GATES = OFF_SDZ + SZ_T2048;
constexpr size_t OFF_HALO = OFF_GATES + (size_t)T_TOK * 64 * 4;
constexpr size_t OFF_WOT = OFF_HALO + (size_t)256 * 3 * 6144 * 2;
constexpr size_t OFF_ROWSS = OFF_WOT + (size_t)2 * 2048 * 2048 * 2;
constexpr size_t OFF_GE = OFF_ROWSS + (size_t)T_TOK * 4;
constexpr size_t OFF_BAR = OFF_GE + 4096 * 4;
constexpr size_t WS_END = OFF_BAR + (size_t)XCD_BAR_WORDS * 4;

struct Params {
    const float *x, *norm_w, *w_in, *ml_i_bias, *ml_f_bias, *ml_norm_w, *dn_conv_w, *dn_a_log, *dn_dt_bias, *dn_norm_w, *w_out, *final_norm_w;
    float* out; unsigned char* ws; int ph_lo, ph_hi; int flags, pad;
};

typedef __bf16 bf16x2_t __attribute__((ext_vector_type(2)));
typedef float f32x2_t __attribute__((ext_vector_type(2)));
DI unsigned pk(float lo, float hi) { const f32x2_t v = {lo, hi}; const bf16x2_t b = __builtin_convertvector(v, bf16x2_t); return __builtin_bit_cast(unsigned, b); }
DI bf16_t f2bf(float f) { return (bf16_t)(pk(f, 0.f) & 0xffffu); }
DI float bf2f(bf16_t b) { return __uint_as_float(((unsigned)b) << 16); }
DI float bflo(unsigned u) { return __uint_as_float(u << 16); }
DI float bfhi(unsigned u) { return __uint_as_float(u & 0xffff0000u); }
DI float sigmoidf_(float x) { return __fdividef(1.f, 1.f + __expf(-x)); }
DI float softplusf_(float x) { return fmaxf(x, 0.f) + log1pf(__expf(-fabsf(x))); }
DI float softcapf_(float x) { return 15.f * tanhf(x * (1.f / 15.f)); }
#define DPPF(old, src, ctrl, rm) __int_as_float(__builtin_amdgcn_update_dpp(__float_as_int(old), __float_as_int(src), (ctrl), (rm), 0xF, false))
DI float dpp_incl_sum(float v) {
    v += DPPF(0.f, v, 0x111, 0xF); v += DPPF(0.f, v, 0x112, 0xF); v += DPPF(0.f, v, 0x114, 0xF); v += DPPF(0.f, v, 0x118, 0xF);
    v += DPPF(0.f, v, 0x142, 0xA); v += DPPF(0.f, v, 0x143, 0xC); return v;
}
DI float dpp_incl_max(float v) {
    const float ninf = -__builtin_huge_valf();
    v = fmaxf(v, DPPF(ninf, v, 0x111, 0xF)); v = fmaxf(v, DPPF(ninf, v, 0x112, 0xF)); v = fmaxf(v, DPPF(ninf, v, 0x114, 0xF)); v = fmaxf(v, DPPF(ninf, v, 0x118, 0xF));
    v = fmaxf(v, DPPF(ninf, v, 0x142, 0xA)); v = fmaxf(v, DPPF(ninf, v, 0x143, 0xC)); return v;
}
DI float fexp(float x) { return __builtin_amdgcn_exp2f(1.4426950408889634f * x); }
DI float flog1pexp_negabs(float x) { return 0.6931471805599453f * __builtin_amdgcn_logf(1.f + __builtin_amdgcn_exp2f(-1.4426950408889634f * fabsf(x))); }
DI float fsoftcap(float x) { const float e = __builtin_amdgcn_exp2f(x * (-2.f * 1.4426950408889634f / 15.f)); return 15.f * (1.f - e) * __builtin_amdgcn_rcpf(1.f + e); }
DI float wave_sum(float v) { for (int d = 32; d >= 1; d >>= 1) v += __shfl_xor(v, d); return v; }
DI float wave_incl_sum(float v, int lane) { for (int d = 1; d < 64; d <<= 1) { float o = __shfl_up(v, d); if (lane >= d) v += o; } return v; }
DI float wave_incl_max(float v, int lane) { for (int d = 1; d < 64; d <<= 1) { float o = __shfl_up(v, d); if (lane >= d) v = fmaxf(v, o); } return v; }
DI void lds_bar() { asm volatile("s_waitcnt lgkmcnt(0)" ::: "memory"); __builtin_amdgcn_s_barrier(); asm volatile("" ::: "memory"); }
DI float row16_sum(float v) {
    v += __int_as_float(__builtin_amdgcn_update_dpp(0, __float_as_int(v), 0xB1, 0xF, 0xF, true));
    v += __int_as_float(__builtin_amdgcn_update_dpp(0, __float_as_int(v), 0x4E, 0xF, 0xF, true));
    v += __int_as_float(__builtin_amdgcn_update_dpp(0, __float_as_int(v), 0x124, 0xF, 0xF, true));
    v += __int_as_float(__builtin_amdgcn_update_dpp(0, __float_as_int(v), 0x128, 0xF, 0xF, true));
    return v;
}
DI float fast_sigmoid(float x) { return __builtin_amdgcn_rcpf(1.f + __builtin_amdgcn_exp2f(-1.4426950408889634f * x)); }
DI void unpack8(const u32x4& r, float (&f)[8]) {
#pragma unroll
    for (int e = 0; e < 4; ++e) { f[2 * e] = bflo(r[e]); f[2 * e + 1] = bfhi(r[e]); }
}
DI u32x4 pack8(const float (&f)[8]) { u32x4 r; r.x = pk(f[0], f[1]); r.y = pk(f[2], f[3]); r.z = pk(f[4], f[5]); r.w = pk(f[6], f[7]); return r; }

template <int KS> DI void mma16(f32x4& acc, const bf16_t* A, int lda, int arow0, const bf16_t* Bt, int ldb, int brow0, int lane) {
    const int r = lane & 15, q = lane >> 4;
    const bf16_t* ap = A + (arow0 + r) * lda + q * 8;
    const bf16_t* bp = Bt + (brow0 + r) * ldb + q * 8;
#pragma unroll
    for (int ks = 0; ks < KS; ++ks) {
        const bf16x8 a = *(const bf16x8*)(ap + ks * 32), b = *(const bf16x8*)(bp + ks * 32);
        acc = __builtin_amdgcn_mfma_f32_16x16x32_bf16(a, b, acc, 0, 0, 0);
    }
}

template <int KS> DI void lda16(bf16x8 (&af)[KS], const bf16_t* A, int lda, int arow0, int lane) {
    const bf16_t* ap = A + (arow0 + (lane & 15)) * lda + (lane >> 4) * 8;
#pragma unroll
    for (int ks = 0; ks < KS; ++ks) af[ks] = *(const bf16x8*)(ap + ks * 32);
}
template <int KS> DI void mma16r(f32x4& acc, const bf16x8 (&af)[KS], const bf16_t* Bt, int ldb, int brow0, int lane) {
    const bf16_t* bp = Bt + (brow0 + (lane & 15)) * ldb + (lane >> 4) * 8;
#pragma unroll
    for (int ks = 0; ks < KS; ++ks) { const bf16x8 b = *(const bf16x8*)(bp + ks * 32); acc = __builtin_amdgcn_mfma_f32_16x16x32_bf16(af[ks], b, acc, 0, 0, 0); }
}
template <int KS> DI void mma16rT(f32x4& acc, const bf16x8 (&af)[KS], const bf16_t* Bt, int ldb, int brow0, int lane) {
    const bf16_t* bp = Bt + (brow0 + (lane & 15)) * ldb + (lane >> 4) * 8;
#pragma unroll
    for (int ks = 0; ks < KS; ++ks) { const bf16x8 b = *(const bf16x8*)(bp + ks * 32); acc = __builtin_amdgcn_mfma_f32_16x16x32_bf16(b, af[ks], acc, 0, 0, 0); }
}
DI int src_col(int np) {
    if (np < 4096) return np;
    if (np < 8192) { const int j = (np - 4096) >> 8, r = (np - 4096) & 255; return r < 128 ? 4096 + 128 * j + r : 6144 + 128 * j + (r - 128); }
    if (np < 14336) return 8208 + (np - 8192);
    if (np < 16384) return 14352 + (np - 14336);
    if (np < 20480) { const int j = (np - 16384) >> 8, r = (np - 16384) & 255; return r < 128 ? 16432 + 128 * j + r : 18480 + 128 * j + (r - 128); }
    if (np < 20496) return 8192 + (np - 20480);
    if (np < 20528) return 16400 + (np - 20496);
    return -1;
}

DI void p0_transpose(const Params& p, unsigned char* lds, int t_lo, int t_hi, int first, int stride) {
    const int tid = threadIdx.x;
    float* tile = (float*)lds;
    constexpr int NT_IN = (NPAD / 256) * 32;
    bf16_t* Wt = (bf16_t*)(p.ws + OFF_WT); bf16_t* WoT = (bf16_t*)(p.ws + OFF_WOT);
    const int g4 = tid & 63, kr = tid >> 6;
#pragma unroll 1
    for (int tix = t_lo + first; tix < t_hi; tix += stride) {
        const float* src; size_t ld; int sc, k0; bf16_t* dst;
        if (tix < NT_IN) { const int ntile = tix >> 5, kt = tix & 31; k0 = kt * 64; sc = src_col(ntile * 256 + g4 * 4); src = p.w_in; ld = IN_DIM; dst = Wt + (size_t)ntile * 256 * 2048; }
        else { const int r = tix - NT_IN, half = r >> 8, r2 = r & 255, ntile = r2 >> 5, kt = r2 & 31; k0 = kt * 64; sc = ntile * 256 + g4 * 4; src = p.w_out + (size_t)half * 2048 * 2048; ld = 2048; dst = WoT + (size_t)half * 2048 * 2048 + (size_t)ntile * 256 * 2048; }
        f32x4 v[8];
#pragma unroll
        for (int i = 0; i < 8; ++i) v[i] = sc >= 0 ? *(const f32x4*)(src + (size_t)(k0 + i * 8 + kr) * ld + sc) : (f32x4){0.f, 0.f, 0.f, 0.f};
#pragma unroll
        for (int i = 0; i < 8; ++i) *(f32x4*)(tile + (i * 8 + kr) * 260 + g4 * 4) = v[i];
        lds_bar();
#pragma unroll
        for (int it = 0; it < 4; ++it) { const int piece = it * 512 + tid, k8 = piece >> 8, n = piece & 255; float f[8];
#pragma unroll
            for (int i = 0; i < 8; ++i) f[i] = tile[(k8 * 8 + i) * 260 + n];
            *(u32x4*)(dst + (size_t)n * 2048 + k0 + k8 * 8) = pack8(f); }
        lds_bar();
    }
}

DI void p0_prologue(const Params& p, unsigned char* lds) {
    const int tid = threadIdx.x, lane = tid & 63, wid = tid >> 6;
    float* rowss = (float*)(p.ws + OFF_ROWSS);
    for (int i = blockIdx.x * 512 + tid; i < T_TOK; i += gridDim.x * 512) rowss[i] = 0.f;
    bf16_t* U = (bf16_t*)(p.ws + OFF_U);
    const int rstep = gridDim.x * 8;
#pragma unroll 1
    for (int row = blockIdx.x * 8 + wid; row < T_TOK; row += 2 * rstep) {
        const int row2 = (row + rstep < T_TOK) ? row + rstep : row;
        const float4* xa = (const float4*)(p.x + (size_t)row * DM); const float4* xb = (const float4*)(p.x + (size_t)row2 * DM);
        float4 va[8], vb[8]; float sa = 0.f, sb = 0.f;
#pragma unroll
        for (int i = 0; i < 8; ++i) { va[i] = xa[i * 64 + lane]; vb[i] = xb[i * 64 + lane]; }
#pragma unroll
        for (int i = 0; i < 8; ++i) { sa += va[i].x * va[i].x + va[i].y * va[i].y + va[i].z * va[i].z + va[i].w * va[i].w; sb += vb[i].x * vb[i].x + vb[i].y * vb[i].y + vb[i].z * vb[i].z + vb[i].w * vb[i].w; }
        sa = wave_sum(sa); sb = wave_sum(sb);
        const float ra = rsqrtf(sa * (1.f / 2048.f) + EPS), rb = rsqrtf(sb * (1.f / 2048.f) + EPS);
#pragma unroll
        for (int i = 0; i < 8; ++i) { const float4 w = ((const float4*)p.norm_w)[i * 64 + lane];
            u32x2 o; o.x = pk(va[i].x * ra * w.x, va[i].y * ra * w.y); o.y = pk(va[i].z * ra * w.z, va[i].w * ra * w.w);
            *(u32x2*)(U + (size_t)row * DM + (i * 64 + lane) * 4) = o;
            u32x2 o2; o2.x = pk(vb[i].x * rb * w.x, vb[i].y * rb * w.y); o2.y = pk(vb[i].z * rb * w.z, vb[i].w * rb * w.w);
            *(u32x2*)(U + (size_t)row2 * DM + (i * 64 + lane) * 4) = o2; }
    }
    p0_transpose(p, lds, 0, (NPAD / 256) * 32, blockIdx.x, gridDim.x);
}

struct EpiProj {
    static constexpr bool PERM = true, AFTER_DRAIN = false;
    unsigned char* ws; unsigned* dout; int flags;
    DI bool operator()(const f32x4 (&acc)[2][2][4][2], const pg8::Unit& u, int wr, int wc, int fr, int fq) const {
        if (flags & 256) return false;
        const int pn = u.pn;
        const int row0 = u.pm * 256 + wr * 64 + fr;
        const int lc = wc * 32 + 8 * fq;
        if (pn < 16 || (pn >= 32 && pn < 56)) {
            bf16_t* base; int ldc, colt; float sc = 1.f; bool halo = false;
            if (pn < 4) { base = (bf16_t*)(ws + OFF_MLQ); ldc = 1024; colt = pn * 256; sc = 0.08838834764831845f; }
            else if (pn < 8) { base = (bf16_t*)(ws + OFF_MLK); ldc = 1024; colt = (pn - 4) * 256; }
            else if (pn < 16) { base = (bf16_t*)(ws + OFF_MLV); ldc = 2048; colt = (pn - 8) * 256; }
            else { base = (bf16_t*)(ws + OFF_DNQKV); ldc = 6144; colt = (pn - 32) * 256; halo = true; }
            bf16_t* hb = (bf16_t*)(ws + OFF_HALO);
#pragma unroll
            for (int ai = 0; ai < 2; ++ai)
#pragma unroll
                for (int m = 0; m < 4; ++m) { const int row = row0 + ai * 128 + m * 16; bf16_t* rowp = base + (size_t)row * ldc + colt + lc;
#pragma unroll
                    for (int bj = 0; bj < 2; ++bj) { const f32x4 v0 = acc[ai][bj][m][0] * sc, v1 = acc[ai][bj][m][1] * sc;
                        u32x4 w; w.x = pk(v0[0], v0[1]); w.y = pk(v0[2], v0[3]); w.z = pk(v1[0], v1[1]); w.w = pk(v1[2], v1[3]);
                        *(u32x4*)(rowp + bj * 128) = w;
                        if (halo && (row & 63) >= 61) *(u32x4*)(hb + ((size_t)(row >> 6) * 3 + ((row & 63) - 61)) * 6144 + colt + lc + bj * 128) = w; } }
        } else if (pn < 32) {
            bf16_t* base = (bf16_t*)(ws + OFF_OZ) + (pn - 16) * 128 + lc;
#pragma unroll
            for (int ai = 0; ai < 2; ++ai)
#pragma unroll
                for (int m = 0; m < 4; ++m) { const int row = row0 + ai * 128 + m * 16; float f[8];
#pragma unroll
                    for (int n = 0; n < 2; ++n)
#pragma unroll
                        for (int i = 0; i < 4; ++i) { const float o = acc[ai][0][m][n][i], z = acc[ai][1][m][n][i];
                            const float eo = __builtin_amdgcn_exp2f(-1.4426950408889634f * o), ez = __builtin_amdgcn_exp2f(-1.4426950408889634f * z); f[n * 4 + i] = z * __builtin_amdgcn_rcpf((1.f + eo) * (1.f + ez)); }
                    *(u32x4*)(base + (size_t)row * 2048) = pack8(f); }
        } else if (pn < 64) {
            bf16_t* base = (bf16_t*)(ws + OFF_SDZ) + (pn - 56) * 256 + lc;
#pragma unroll
            for (int ai = 0; ai < 2; ++ai)
#pragma unroll
                for (int m = 0; m < 4; ++m) { const int row = row0 + ai * 128 + m * 16;
#pragma unroll
                    for (int bj = 0; bj < 2; ++bj) { float f[8];
#pragma unroll
                        for (int n = 0; n < 2; ++n)
#pragma unroll
                            for (int i = 0; i < 4; ++i) { const float z = acc[ai][bj][m][n][i]; f[n * 4 + i] = z * fast_sigmoid(z); }
                        *(u32x4*)(base + (size_t)row * 2048 + bj * 128) = pack8(f); } }
        } else if (pn < 80) {
            unsigned* base = dout + (pn - 64) * 128 + lc;
#pragma unroll
            for (int ai = 0; ai < 2; ++ai)
#pragma unroll
                for (int m = 0; m < 4; ++m) { const int row = row0 + ai * 128 + m * 16;
#pragma unroll
                    for (int n = 0; n < 2; ++n) { u32x4 w;
#pragma unroll
                        for (int i = 0; i < 4; ++i) { const float ea = __builtin_amdgcn_exp2f(-1.4426950408889634f * acc[ai][0][m][n][i]), eb = __builtin_amdgcn_exp2f(-1.4426950408889634f * acc[ai][1][m][n][i]);
                            const float hb = fminf(1.f + eb, 1e30f);
                            w[i] = pk(__builtin_amdgcn_rcpf(1.f + ea) * hb, hb); }
                        *(u32x4*)(base + (size_t)row * 2048 + 4 * n) = w; } }
        } else {
            if (wc < 2) { float* base = (float*)(ws + OFF_GATES) + lc;
#pragma unroll
                for (int ai = 0; ai < 2; ++ai)
#pragma unroll
                    for (int m = 0; m < 4; ++m) { const int row = row0 + ai * 128 + m * 16;
#pragma unroll
                        for (int n = 0; n < 2; ++n) *(f32x4*)(base + (size_t)row * 64 + 4 * n) = acc[ai][0][m][n]; } }
        }
        return false;
    }
};

struct SuperTileOrder {
    int G, c;
    DI bool next(int i, pg8::Unit& u) const {
        if (G != 256) { const long L = (long)i * G + c; if (L >= 64 * 81) return false; u.pm = (int)(L % 64); u.pn = (int)(L / 64); return true; }
        const int x = c & 7, j = c >> 3;
        if (i < 20) { const int R = i / 5, Cc = i - R * 5; u.pm = R * 16 + (x & 1) * 8 + (j & 7); u.pn = Cc * 16 + (x >> 1) * 4 + (j >> 3); return true; }
        if (i == 20 && j < 8) { u.pm = x * 8 + j; u.pn = 80; return true; }
        return false;
    }
    DI void a_ready(const pg8::Unit&) const {}
    DI void done(const pg8::Unit&) const {}
};
constexpr int A_B_TILE_OFS = (int)((OFF_SDZ - OFF_MLV) / ((size_t)256 * 2048 * 2));
static_assert((OFF_SDZ - OFF_MLV) % ((size_t)256 * 2048 * 2) == 0, "A_b must sit a whole number of 256-row tiles after A_a");
struct EpiOut {
    static constexpr bool PERM = false, AFTER_DRAIN = false;
    const float* x; float* out; float* rowss;
    DI bool operator()(f32x4 (&acc)[2][2][4][2], const pg8::Unit& u, int wr, int wc, int fr, int fq) const {
        const bool half = u.pm >= 64; const int pm = half ? u.pm - A_B_TILE_OFS : u.pm, pn = u.pn & 7;
        const int row0 = pm * 256 + wr * 64 + fr, col0 = pn * 256 + wc * 32 + 4 * fq;
#pragma unroll
        for (int ai = 0; ai < 2; ++ai)
#pragma unroll
            for (int m = 0; m < 4; ++m) { const int row = row0 + ai * 128 + m * 16; const size_t off = (size_t)row * 2048 + col0; float ss = 0.f;
#pragma unroll
                for (int bj = 0; bj < 2; ++bj)
#pragma unroll
                    for (int n = 0; n < 2; ++n) { const size_t o = off + bj * 128 + n * 16; const u32x4 pr = *(const u32x4*)((const unsigned*)out + o);
                        if (!half) { f32x4 r; r[0] = bflo(pr[0]); r[1] = bflo(pr[1]); r[2] = bflo(pr[2]); r[3] = bflo(pr[3]);
                            acc[ai][bj][m][n] *= r; }
                        else { f32x4 gb; gb[0] = __builtin_amdgcn_rcpf(bfhi(pr[0])); gb[1] = __builtin_amdgcn_rcpf(bfhi(pr[1])); gb[2] = __builtin_amdgcn_rcpf(bfhi(pr[2])); gb[3] = __builtin_amdgcn_rcpf(bfhi(pr[3]));
                            const f32x4 xv = *(const f32x4*)(x + o); const f32x4 hh = xv + gb * acc[ai][bj][m][n];
                            *(f32x4*)(out + o) = hh; ss += hh[0] * hh[0] + hh[1] * hh[1] + hh[2] * hh[2] + hh[3] * hh[3]; } }
                if (half) { ss += __shfl_xor(ss, 16); ss += __shfl_xor(ss, 32); if (fq == 0) atomicAdd(rowss + row, ss); }
                asm volatile("" ::: "memory"); }
        return !half;
    }
};
struct OutOrder {
    pg8::StaticOrder so;
    DI bool next(int i, pg8::Unit& u) const { pg8::Unit t; if (!so.next(i >> 1, t)) return false; const int half = i & 1; u.pm = t.pm + A_B_TILE_OFS * half; u.pn = t.pn + 8 * half; return true; }
    DI void a_ready(const pg8::Unit&) const {}
    DI void done(const pg8::Unit&) const {}
};

DI void p2_dnprep(const Params& p, unsigned char* lds) {
    const int tid = threadIdx.x, lane = tid & 63, wid = tid >> 6, q = lane >> 4, cl = lane & 15;
    bf16_t* sraw = (bf16_t*)lds;
    float* sR = (float*)lds;
    bf16_t* sqn = (bf16_t*)(lds + 52736);
    bf16_t* skn = sqn + 64 * 136;
    bf16_t* svn = skn + 64 * 136;
    float* sA = (float*)(lds + 104960);
    float* sbeta = (float*)(lds + 125440);
    float* sgam = sbeta + 64; float* sbg = sgam + 64;
    float* scw = (float*)(lds + 126208);
    float* sT = (float*)(lds + 132352);
    bf16_t* DNQKV = (bf16_t*)(p.ws + OFF_DNQKV); const bf16_t* HALO = (const bf16_t*)(p.ws + OFF_HALO);
    const float* GATES = (const float*)(p.ws + OFF_GATES); bf16_t* WK = (bf16_t*)(p.ws + OFF_WK); bf16_t* QK = (bf16_t*)(p.ws + OFF_QK);
    float* GE = (float*)(p.ws + OFF_GE);
    const int h = blockIdx.x & 15, bstep = gridDim.x >> 4;
    for (int i = tid; i < 1536; i += 512) { const int j = i / 384, r = i - j * 384, which = r >> 7, c = r & 127; scw[i] = p.dn_conv_w[(size_t)j * 6144 + which * 2048 + h * 128 + c]; }
    const float alog = -__expf(p.dn_a_log[h]), dtb = p.dn_dt_bias[h];
    u32x4 pre[7]; float pgb = 0.f, pga = 0.f;
#define P2_LOAD(bcc) do { const int bc_ = (bcc), c_ = bc_ & 31, t0_ = bc_ * 64; \
        _Pragma("unroll") for (int i = 0; i < 7; ++i) { const int idx = tid + 512 * i; u32x4 v = {0u, 0u, 0u, 0u}; \
            if (idx < 67 * 48) { const int r = idx / 48, pc = idx - r * 48, seg = pc >> 4, c8 = (pc & 15) * 8, colg = seg * 2048 + h * 128 + c8; \
                if (r >= 3) v = *(const u32x4*)(DNQKV + (size_t)(t0_ + r - 3) * 6144 + colg); \
                else if (c_ > 0) v = *(const u32x4*)(HALO + ((size_t)(bc_ - 1) * 3 + r) * 6144 + colg); } \
            pre[i] = v; } \
        if (wid == 0) { pgb = GATES[(size_t)(t0_ + lane) * 64 + 16 + h]; pga = GATES[(size_t)(t0_ + lane) * 64 + 32 + h]; } } while (0)
    int bc = blockIdx.x >> 4;
    if (p.flags & 32) bc = 256;
    if (bc < 256) P2_LOAD(bc);
#pragma unroll 1
    for (; bc < 256; bc += bstep) {
        const int t0 = bc * 64; const int item = bc * 16 + h;
#pragma unroll
        for (int i = 0; i < 7; ++i) { const int idx = tid + 512 * i; if (idx < 67 * 48) { const int r = idx / 48, pc = idx - r * 48, seg = pc >> 4, c8 = (pc & 15) * 8; *(u32x4*)(sraw + r * 392 + seg * 128 + c8) = pre[i]; } }
        if (wid == 0) { const float beta = fast_sigmoid(pgb); const float xs = pga + dtb; const float g = alog * (fmaxf(xs, 0.f) + flog1pexp_negabs(xs));
            const float gam = dpp_incl_sum(g); sbeta[lane] = beta; sgam[lane] = gam; sbg[lane] = beta * fexp(gam);
            if (lane == 63) GE[item] = fexp(gam); }
        lds_bar();
        if (bc + bstep < 256) P2_LOAD(bc + bstep);
        if (!(p.flags & 2))
#pragma unroll 3
        for (int it = 0; it < 6; ++it) { const int idx = it * 512 + tid, cg16 = idx & 15, st = idx >> 4, which = st >> 6, t = st & 63, col = which * 128 + cg16 * 8;
            float y[8];
#pragma unroll
            for (int e = 0; e < 8; ++e) y[e] = 0.f;
#pragma unroll
            for (int j = 0; j < 4; ++j) { const u32x4 rv = *(const u32x4*)(sraw + (t + j) * 392 + col); float xv[8]; unpack8(rv, xv);
                const f32x4 w0 = *(const f32x4*)(scw + j * 384 + col), w1 = *(const f32x4*)(scw + j * 384 + col + 4);
#pragma unroll
                for (int e = 0; e < 4; ++e) { y[e] += w0[e] * xv[e]; y[4 + e] += w1[e] * xv[4 + e]; } }
            float ss = 0.f;
#pragma unroll
            for (int e = 0; e < 8; ++e) { y[e] = y[e] * fast_sigmoid(y[e]); ss += y[e] * y[e]; }
            ss = row16_sum(ss);
            const float scale = which == 2 ? 1.f : rsqrtf(ss + EPS) * (which == 0 ? 0.08838834764831845f : 1.f);
#pragma unroll
            for (int e = 0; e < 8; ++e) y[e] *= scale;
            bf16_t* dst = (which == 0 ? sqn : (which == 1 ? skn : svn)) + t * 136 + cg16 * 8;
            *(u32x4*)dst = pack8(y); }
        lds_bar();
        if (!(p.flags & 4)) { const int tr = wid >> 1, tcb = (wid & 1) * 2;
#pragma unroll
            for (int ti = 0; ti < 2; ++ti) { const int tc = tcb + ti; f32x4 akk = {0.f, 0.f, 0.f, 0.f}, aqk = {0.f, 0.f, 0.f, 0.f};
                if (tc <= tr) { mma16<4>(akk, skn, 136, tr * 16, skn, 136, tc * 16, lane); mma16<4>(aqk, sqn, 136, tr * 16, skn, 136, tc * 16, lane); }
                f32x4 av;
#pragma unroll
                for (int reg = 0; reg < 4; ++reg) { const int t = tr * 16 + q * 4 + reg, s = tc * 16 + cl; const float dec = (s <= t) ? fexp(sgam[t] - sgam[s]) : 0.f;
                    av[reg] = (s < t) ? sbeta[t] * akk[reg] * dec : 0.f;
                    QK[(size_t)(t0 + t) * 1024 + h * 64 + s] = f2bf(aqk[reg] * dec); }
                *(f32x4*)(sA + (tc * 16 + cl) * 80 + tr * 16 + q * 4) = av; } }
        { const float glast = sgam[63];
#pragma unroll
            for (int it = 0; it < 2; ++it) { const int rem = it * 512 + tid, t = rem >> 4, c8 = (rem & 15) * 8;
                const float sc = fexp(sgam[t]);
                float f[8]; unpack8(*(const u32x4*)(sqn + t * 136 + c8), f);
#pragma unroll
                for (int e = 0; e < 8; ++e) f[e] *= sc;
                *(u32x4*)(DNQKV + (size_t)(t0 + t) * 6144 + h * 128 + c8) = pack8(f); }
            { const int t = lane; const float sc = fexp(glast - sgam[t]);
#pragma unroll
                for (int i = 0; i < 2; ++i) { const int d8 = (wid * 2 + i) * 8; float f[8]; unpack8(*(const u32x4*)(skn + t * 136 + d8), f);
#pragma unroll
                    for (int e = 0; e < 8; ++e) { const int dk = d8 + e; DNQKV[(size_t)(t0 + (dk >> 1)) * 6144 + 2048 + h * 128 + (dk & 1) * 64 + t] = f2bf(f[e] * sc); } } } }
        lds_bar();
        if (wid < 4 && !(p.flags & 8)) { const int I = wid, j = lane & 15; float x[16];
            const f32x4 av = *(const f32x4*)(sA + (16 * I + (lane >> 2)) * 80 + 16 * I + (lane & 3) * 4);
#pragma unroll
            for (int i = 0; i < 16; ++i) x[i] = (i == j) ? 1.f : 0.f;
#pragma unroll
            for (int k = 0; k < 15; ++k) { const float xk = x[k];
#pragma unroll
                for (int i = k + 1; i < 16; ++i) { const float ae = av[i & 3]; const float a = __int_as_float(__builtin_amdgcn_readlane(__float_as_int(ae), k * 4 + (i >> 2))); x[i] -= a * xk; } }
            if (lane < 16) {
#pragma unroll
                for (int i = 0; i < 16; ++i) sT[I * 272 + i * 17 + j] = x[i]; } }
        if (wid >= 4) {
#pragma unroll
        for (int it = 0; it < 8; ++it) { const int idx = it * 256 + (tid - 256), which = idx >> 10, rem = idx & 1023, t = rem >> 4, c8 = (rem & 15) * 8;
            const float sc = which == 0 ? sbeta[t] : sbg[t];
            float f[8]; unpack8(*(const u32x4*)((which == 0 ? svn : skn) + t * 136 + c8), f);
            f32x4 o0, o1;
#pragma unroll
            for (int e = 0; e < 4; ++e) { o0[e] = f[e] * sc; o1[e] = f[4 + e] * sc; }
            float* d = sR + t * 272 + which * 128 + c8; *(f32x4*)d = o0; *(f32x4*)(d + 4) = o1; } }
        lds_bar();
        if (!(p.flags & 1)) {
            const int c0a = wid * 32 + cl, c0b = c0a + 16;
#pragma unroll
            for (int I = 0; I < 4; ++I) {
                if (I > 0) {
                    f32x4 acc0, acc1; float af[12], b0[12], b1[12];
#pragma unroll
                    for (int reg = 0; reg < 4; ++reg) { acc0[reg] = sR[(16 * I + q * 4 + reg) * 272 + c0a]; acc1[reg] = sR[(16 * I + q * 4 + reg) * 272 + c0b]; }
#pragma unroll
                    for (int kk = 0; kk < 4 * I; ++kk) { af[kk] = -sA[(4 * kk + q) * 80 + 16 * I + cl]; b0[kk] = sR[(4 * kk + q) * 272 + c0a]; b1[kk] = sR[(4 * kk + q) * 272 + c0b]; }
#pragma unroll
                    for (int kk = 0; kk < 4 * I; ++kk) { acc0 = __builtin_amdgcn_mfma_f32_16x16x4f32(af[kk], b0[kk], acc0, 0, 0, 0); acc1 = __builtin_amdgcn_mfma_f32_16x16x4f32(af[kk], b1[kk], acc1, 0, 0, 0); }
#pragma unroll
                    for (int reg = 0; reg < 4; ++reg) { sR[(16 * I + q * 4 + reg) * 272 + c0a] = acc0[reg]; sR[(16 * I + q * 4 + reg) * 272 + c0b] = acc1[reg]; }
                }
                { float ta[4], d0[4], d1[4]; f32x4 x0 = {0.f, 0.f, 0.f, 0.f}, x1 = {0.f, 0.f, 0.f, 0.f};
#pragma unroll
                    for (int kk = 0; kk < 4; ++kk) { ta[kk] = sT[I * 272 + cl * 17 + 4 * kk + q]; d0[kk] = sR[(16 * I + 4 * kk + q) * 272 + c0a]; d1[kk] = sR[(16 * I + 4 * kk + q) * 272 + c0b]; }
#pragma unroll
                    for (int kk = 0; kk < 4; ++kk) { x0 = __builtin_amdgcn_mfma_f32_16x16x4f32(ta[kk], d0[kk], x0, 0, 0, 0); x1 = __builtin_amdgcn_mfma_f32_16x16x4f32(ta[kk], d1[kk], x1, 0, 0, 0); }
#pragma unroll
                    for (int reg = 0; reg < 4; ++reg) { sR[(16 * I + q * 4 + reg) * 272 + c0a] = x0[reg]; sR[(16 * I + q * 4 + reg) * 272 + c0b] = x1[reg]; }
                }
            }
        }
        lds_bar();
#pragma unroll
        for (int it = 0; it < 4; ++it) { const int idx = it * 512 + tid, which = idx >> 10, rem = idx & 1023, t = rem >> 4, c8 = (rem & 15) * 8;
            const float* d = sR + t * 272 + which * 128 + c8; const f32x4 o0 = *(const f32x4*)d, o1 = *(const f32x4*)(d + 4);
            u32x4 w; w.x = pk(o0[0], o0[1]); w.y = pk(o0[2], o0[3]); w.z = pk(o1[0], o1[1]); w.w = pk(o1[2], o1[3]);
            if (which == 0) *(u32x4*)(DNQKV + (size_t)(t0 + t) * 6144 + 4096 + h * 128 + c8) = w;
            else *(u32x4*)(WK + (size_t)(t0 + t) * 2048 + h * 128 + c8) = w; }
        lds_bar();
    }
#undef P2_LOAD
}

DI void scan_dn(const Params& p, unsigned char* lds, int item) {
    const int tid = threadIdx.x, lane = tid & 63, wid = tid >> 6, q = lane >> 4, cl = lane & 15;
    const int b = item >> 4, h = item & 15;
    bf16_t* swk = (bf16_t*)lds;
    bf16_t* sqd = swk + 64 * 136;
    bf16_t* swv = sqd + 64 * 136;
    bf16_t* sqk = swv + 64 * 136;
    bf16_t* skeT = sqk + 64 * 72;
    bf16_t* suT = skeT + 128 * 72;
    bf16_t* sSt = suT + 128 * 72;
    bf16_t* ssz = sSt + 128 * 136;
    float* sssq = (float*)(ssz + 64 * 136);
    bf16_t* SDZ = (bf16_t*)(p.ws + OFF_SDZ);
    bf16_t* DNQKV = (bf16_t*)(p.ws + OFF_DNQKV); const bf16_t* WK = (const bf16_t*)(p.ws + OFF_WK); const bf16_t* QK = (const bf16_t*)(p.ws + OFF_QK);
    const float* GE = (const float*)(p.ws + OFF_GE);
    for (int i = tid; i < 128 * 136 / 2; i += 512) ((unsigned*)sSt)[i] = 0u;
    f32x4 accS[8];
#pragma unroll
    for (int i = 0; i < 8; ++i) accS[i] = (f32x4){0.f, 0.f, 0.f, 0.f};
    bf16_t* oout = SDZ + (size_t)b * 2048 * 2048 + h * 128;
    u32x4 rwk[2], rqd[2], rke[2], rwv[2], rsz[2], rqk; float ge;
    f32x4 nw[4];
#pragma unroll
    for (int j = 0; j < 4; ++j) nw[j] = *(const f32x4*)(p.dn_norm_w + ((wid >> 2) * 4 + j) * 16 + q * 4);
#define DN_LOAD(cc) do { const size_t tb = (size_t)b * 2048 + (size_t)(cc) * 64; \
        _Pragma("unroll") for (int i = 0; i < 2; ++i) { const int piece = tid + 512 * i, t = piece >> 4, c8 = (piece & 15) * 8; const size_t ro = (tb + t) * 6144 + h * 128 + c8; \
            rwk[i] = *(const u32x4*)(WK + (tb + t) * 2048 + h * 128 + c8); rqd[i] = *(const u32x4*)(DNQKV + ro); rke[i] = *(const u32x4*)(DNQKV + ro + 2048); rwv[i] = *(const u32x4*)(DNQKV + ro + 4096); rsz[i] = *(const u32x4*)(SDZ + (tb + t) * 2048 + h * 128 + c8); } \
        rqk = *(const u32x4*)(QK + (tb + (tid >> 3)) * 1024 + h * 64 + (tid & 7) * 8); \
        ge = GE[((size_t)(b * 32 + (cc))) * 16 + h]; } while (0)
    DN_LOAD(0);
    lds_bar();
#pragma unroll 1
    for (int c = 0; c < 32; ++c) {
        const size_t t0 = (size_t)b * 2048 + (size_t)c * 64;
#pragma unroll
        for (int i = 0; i < 2; ++i) { const int piece = tid + 512 * i, t = piece >> 4, c8 = (piece & 15) * 8;
            *(u32x4*)(swk + t * 136 + c8) = rwk[i]; *(u32x4*)(sqd + t * 136 + c8) = rqd[i]; *(u32x4*)(swv + t * 136 + c8) = rwv[i]; *(u32x4*)(ssz + t * 136 + c8) = rsz[i];
            *(u32x4*)(skeT + (2 * t + (c8 >> 6)) * 72 + (c8 & 63)) = rke[i]; }
        *(u32x4*)(sqk + (tid >> 3) * 72 + (tid & 7) * 8) = rqk;
        const float gec = ge;
        if (c + 1 < 32) DN_LOAD(c + 1);
        lds_bar();
        const int tr = wid & 3, hb = (wid >> 2) * 4;
        bf16x8 afk[4]; lda16<4>(afk, swk, 136, tr * 16, lane);
#pragma unroll
        for (int j = 0; j < 4; ++j) { const int nt = hb + j; f32x4 a = {0.f, 0.f, 0.f, 0.f};
            mma16r<4>(a, afk, sSt, 136, nt * 16, lane);
            const int dv = nt * 16 + cl, tq = tr * 16 + q * 4;
            const float u0 = bf2f(swv[(tq + 0) * 136 + dv]) - a[0], u1 = bf2f(swv[(tq + 1) * 136 + dv]) - a[1], u2 = bf2f(swv[(tq + 2) * 136 + dv]) - a[2], u3 = bf2f(swv[(tq + 3) * 136 + dv]) - a[3];
            u32x2 w; w.x = pk(u0, u1); w.y = pk(u2, u3); *(u32x2*)(suT + dv * 72 + tq) = w; }
        lds_bar();
        bf16x8 afq[4], afs[2]; lda16<4>(afq, sqd, 136, tr * 16, lane); lda16<2>(afs, sqk, 72, tr * 16, lane);
        f32x4 ao[4]; float psq = 0.f;
        const int to = tr * 16 + cl;
#pragma unroll
        for (int j = 0; j < 4; ++j) { const int nt = hb + j; ao[j] = (f32x4){0.f, 0.f, 0.f, 0.f};
            mma16rT<4>(ao[j], afq, sSt, 136, nt * 16, lane);
            mma16rT<2>(ao[j], afs, suT, 72, nt * 16, lane);
            psq += ao[j][0] * ao[j][0] + ao[j][1] * ao[j][1] + ao[j][2] * ao[j][2] + ao[j][3] * ao[j][3];
            const u32x2 zz = *(const u32x2*)(ssz + to * 136 + nt * 16 + q * 4);
            ao[j][0] *= nw[j][0] * bflo(zz.x); ao[j][1] *= nw[j][1] * bfhi(zz.x); ao[j][2] *= nw[j][2] * bflo(zz.y); ao[j][3] *= nw[j][3] * bfhi(zz.y); }
        psq += __shfl_xor(psq, 16); psq += __shfl_xor(psq, 32);
        if (q == 0) sssq[(wid >> 2) * 64 + to] = psq;
        bf16x8 afe[2]; lda16<2>(afe, skeT, 72, wid * 16, lane);
#pragma unroll
        for (int nt = 0; nt < 8; ++nt) { accS[nt] *= gec; mma16r<2>(accS[nt], afe, suT, 72, nt * 16, lane); if (nt & 1) asm volatile("" ::: "memory"); }
        lds_bar();
#pragma unroll
        for (int nt = 0; nt < 8; ++nt) { const int dv = nt * 16 + cl, dk0 = wid * 16 + q * 4; u32x2 w; w.x = pk(accS[nt][0], accS[nt][1]); w.y = pk(accS[nt][2], accS[nt][3]); *(u32x2*)(sSt + dv * 136 + dk0) = w; }
        { const float rs = rsqrtf((sssq[to] + sssq[64 + to]) * (1.f / 128.f) + EPS);
#pragma unroll
            for (int j = 0; j < 4; ++j) { u32x2 w; w.x = pk(ao[j][0] * rs, ao[j][1] * rs); w.y = pk(ao[j][2] * rs, ao[j][3] * rs);
                *(u32x2*)(oout + (unsigned)((c * 64 + to) * 2048 + (hb + j) * 16 + q * 4)) = w; } }
    }
#undef DN_LOAD
    lds_bar();
}

DI void scan_ml(const Params& p, unsigned char* lds, int item) {
    const int tid = threadIdx.x, lane = tid & 63, wid = tid >> 6, q = lane >> 4, cl = lane & 15;
    const int b = item >> 4, h = (item >> 1) & 7, sl = item & 1, vcol = h * 256 + sl * 128;
    bf16_t* sq = (bf16_t*)lds;
    bf16_t* sk = sq + 64 * 136;
    bf16_t* sCt = sk + 64 * 136;
    bf16_t* skwT = sCt + 144 * 136;
    bf16_t* sVt = skwT + 128 * 72;
    bf16_t* sP = sVt + 144 * 72;
    float* sf = (float*)(sP + 64 * 72);
    float *s_bcum = sf, *s_a = sf + 64, *s_mt = sf + 128, *s_iw = sf + 192, *s_emt = sf + 256, *s_ew = sf + 320, *s_sc = sf + 384;
    bf16_t* sv = (bf16_t*)(lds + 124416);
    const bf16_t* MLQ = (const bf16_t*)(p.ws + OFF_MLQ); const bf16_t* MLK = (const bf16_t*)(p.ws + OFF_MLK); bf16_t* MLV = (bf16_t*)(p.ws + OFF_MLV);
    const float* GATES = (const float*)(p.ws + OFF_GATES);
    for (int i = tid; i < 144 * 136 / 2; i += 512) ((unsigned*)sCt)[i] = 0u;
    for (int i = tid; i < 16 * 72; i += 512) sVt[128 * 72 + i] = (i < 72) ? (bf16_t)0x3F80u : (bf16_t)0u;
    f32x4 accC[9];
#pragma unroll
    for (int i = 0; i < 9; ++i) accC[i] = (f32x4){0.f, 0.f, 0.f, 0.f};
    const float ibias = p.ml_i_bias[h], fbias = p.ml_f_bias[h];
    bf16_t* hout = MLV + (size_t)b * 2048 * 2048 + vcol;
    float m_run = 0.f;
    u32x4 rq[2], rk[2], rv[2]; float gi = 0.f, gf = 0.f;
#define ML_LOAD(cc) do { const size_t tb = (size_t)b * 2048 + (size_t)(cc) * 64; \
        _Pragma("unroll") for (int i = 0; i < 2; ++i) { const int piece = tid + 512 * i, t = piece >> 4, c8 = (piece & 15) * 8; \
            rq[i] = *(const u32x4*)(MLQ + (tb + t) * 1024 + h * 128 + c8); rk[i] = *(const u32x4*)(MLK + (tb + t) * 1024 + h * 128 + c8); rv[i] = *(const u32x4*)(MLV + (tb + t) * 2048 + vcol + c8); } \
        if (wid == 0) { gi = GATES[(tb + lane) * 64 + h]; gf = GATES[(tb + lane) * 64 + 8 + h]; } } while (0)
    ML_LOAD(0);
    lds_bar();
#pragma unroll 1
    for (int c = 0; c < 32; ++c) {
        const size_t t0 = (size_t)b * 2048 + (size_t)c * 64;
#pragma unroll
        for (int i = 0; i < 2; ++i) { const int piece = tid + 512 * i, t = piece >> 4, c8 = (piece & 15) * 8;
            *(u32x4*)(sq + t * 136 + c8) = rq[i]; *(u32x4*)(sk + t * 136 + c8) = rk[i]; *(u32x4*)(sv + t * 136 + c8) = rv[i]; }
        if (wid == 0) {
            const float ipre = fsoftcap(gi + ibias); const float fc = fsoftcap(gf + fbias); const float lf = fminf(fc, 0.f) - flog1pexp_negabs(fc);
            const float bcum = dpp_incl_sum(lf); const float a = ipre - bcum; const float pm = dpp_incl_max(a);
            const float bl = __int_as_float(__builtin_amdgcn_readlane(__float_as_int(bcum), 63)), pml = __int_as_float(__builtin_amdgcn_readlane(__float_as_int(pm), 63));
            const float il = bcum + m_run, mt = fmaxf(il, bcum + pm);
            const float mnew = fmaxf(bl + m_run, bl + pml);
            s_bcum[lane] = bcum; s_a[lane] = a; s_mt[lane] = mt; s_iw[lane] = fexp(il - mt); s_emt[lane] = fexp(-mt); s_ew[lane] = fexp(bl + a - mnew);
            if (lane == 0) s_sc[0] = fexp(bl + m_run - mnew);
            m_run = mnew;
        }
        if (c + 1 < 32) ML_LOAD(c + 1);
        lds_bar();
#pragma unroll
        for (int i = 0; i < 2; ++i) { const int t = lane, d8 = (wid * 2 + i) * 8; float f[8]; unpack8(*(const u32x4*)(sk + t * 136 + d8), f); const float ew = s_ew[t];
#pragma unroll
            for (int e = 0; e < 8; ++e) skwT[(d8 + e) * 72 + t] = f2bf(f[e] * ew); }
        asm volatile("" ::: "memory");
#pragma unroll
        for (int i = 0; i < 2; ++i) { const int t = lane, d8 = (wid * 2 + i) * 8; const u32x4 vv = *(const u32x4*)(sv + t * 136 + d8);
#pragma unroll
            for (int e = 0; e < 8; ++e) sVt[(d8 + e) * 72 + t] = (bf16_t)((vv[e >> 1] >> ((e & 1) * 16)) & 0xffffu); }
        asm volatile("" ::: "memory");
        { const int tr = wid >> 1, tcb = (wid & 1) * 2;
            bf16x8 afq[4]; lda16<4>(afq, sq, 136, tr * 16, lane);
#pragma unroll
            for (int ti = 0; ti < 2; ++ti) { const int tc = tcb + ti; f32x4 a = {0.f, 0.f, 0.f, 0.f};
                if (tc <= tr) mma16r<4>(a, afq, sk, 136, tc * 16, lane);
#pragma unroll
                for (int reg = 0; reg < 4; ++reg) { const int t = tr * 16 + q * 4 + reg, s = tc * 16 + cl;
                    const float w = (s <= t) ? fexp(s_bcum[t] + s_a[s] - s_mt[t]) * a[reg] : 0.f;
                    sP[t * 72 + s] = f2bf(w); } } }
        lds_bar();
        { const int tr = wid & 3, hb = (wid >> 2) * 4, tq = tr * 16 + q * 4;
            f32x4 an[5];
#pragma unroll
            for (int j = 0; j < 5; ++j) { const int nt = j < 4 ? hb + j : 8; an[j] = (f32x4){0.f, 0.f, 0.f, 0.f}; mma16<4>(an[j], sq, 136, tr * 16, sCt, 136, nt * 16, lane); asm volatile("" ::: "memory"); }
            bf16x8 afp[2]; lda16<2>(afp, sP, 72, tr * 16, lane);
            f32x4 iw; iw[0] = s_iw[tq]; iw[1] = s_iw[tq + 1]; iw[2] = s_iw[tq + 2]; iw[3] = s_iw[tq + 3];
#pragma unroll
            for (int j = 0; j < 5; ++j) { const int nt = j < 4 ? hb + j : 8; an[j] *= iw; mma16r<2>(an[j], afp, sVt, 72, nt * 16, lane); }
            float rden[4];
#pragma unroll
            for (int reg = 0; reg < 4; ++reg) { const float den = __shfl(an[4][reg], lane & 48); rden[reg] = __builtin_amdgcn_rcpf(fmaxf(fabsf(den), s_emt[tq + reg])); }
#pragma unroll
            for (int j = 0; j < 4; ++j) { const int dv = (hb + j) * 16 + cl;
#pragma unroll
                for (int reg = 0; reg < 4; ++reg) hout[(unsigned)((c * 64 + tq + reg) * 2048 + dv)] = f2bf(an[j][reg] * rden[reg]); }
            const float decay = s_sc[0];
            bf16x8 afw[2]; lda16<2>(afw, skwT, 72, wid * 16, lane);
#pragma unroll
            for (int nt = 0; nt < 9; ++nt) { accC[nt] *= decay; mma16r<2>(accC[nt], afw, sVt, 72, nt * 16, lane); if (nt & 1) asm volatile("" ::: "memory"); }
        }
        lds_bar();
#pragma unroll
        for (int nt = 0; nt < 9; ++nt) { const int dv = nt * 16 + cl, dk0 = wid * 16 + q * 4; u32x2 w; w.x = pk(accC[nt][0], accC[nt][1]); w.y = pk(accC[nt][2], accC[nt][3]); *(u32x2*)(sCt + dv * 136 + dk0) = w; }
    }
#undef ML_LOAD
    lds_bar();
}

DI void p4_normgate(const Params& p) {
    const int tid = threadIdx.x, lane = tid & 63, wid = tid >> 6;
    bf16_t* MLV = (bf16_t*)(p.ws + OFF_MLV); const bf16_t* OZ = (const bf16_t*)(p.ws + OFF_OZ);
    const bf16_t* DNQKV = (const bf16_t*)(p.ws + OFF_DNQKV); const bf16_t* SDZ = (const bf16_t*)(p.ws + OFF_SDZ); bf16_t* AB = (bf16_t*)(p.ws + OFF_MLQ);
    for (int tok = blockIdx.x * 8 + wid; tok < T_TOK; tok += gridDim.x * 8) {
#pragma unroll
        for (int it = 0; it < 4; ++it) { const int c0 = it * 512 + lane * 8; float hv[8], gv[8];
            unpack8(*(const u32x4*)(MLV + (size_t)tok * 2048 + c0), hv); unpack8(*(const u32x4*)(OZ + (size_t)tok * 2048 + c0), gv);
            float ss = 0.f;
#pragma unroll
            for (int e = 0; e < 8; ++e) ss += hv[e] * hv[e];
            ss = row16_sum(ss); ss += __shfl_xor(ss, 16);
            const float rs = rsqrtf(ss * (1.f / 256.f) + EPS);
            const float4 w0 = *(const float4*)(p.ml_norm_w + c0), w1 = *(const float4*)(p.ml_norm_w + c0 + 4);
            const float w[8] = {w0.x, w0.y, w0.z, w0.w, w1.x, w1.y, w1.z, w1.w};
#pragma unroll
            for (int e = 0; e < 8; ++e) hv[e] = hv[e] * rs * w[e] * gv[e];
            *(u32x4*)(MLV + (size_t)tok * 2048 + c0) = pack8(hv); }
    }
}

DI void p6_final(const Params& p) {
    const int tid = threadIdx.x, lane = tid & 63, wid = tid >> 6;
    const float* rowss = (const float*)(p.ws + OFF_ROWSS);
    for (int tok = blockIdx.x * 8 + wid; tok < T_TOK; tok += gridDim.x * 8) {
        const float rs = rsqrtf(rowss[tok] * (1.f / 2048.f) + EPS);
        float4* o = (float4*)(p.out + (size_t)tok * 2048);
#pragma unroll
        for (int i = 0; i < 8; ++i) { float4 v = o[i * 64 + lane]; const float4 w = ((const float4*)p.final_norm_w)[i * 64 + lane];
            v.x *= rs * w.x; v.y *= rs * w.y; v.z *= rs * w.z; v.w *= rs * w.w; o[i * 64 + lane] = v; }
    }
}


#ifdef DBG
DI void p7_debug(const Params& p) {
    const bf16_t* MLV = (const bf16_t*)(p.ws + OFF_MLV); const bf16_t* MLQ = (const bf16_t*)(p.ws + OFF_MLQ); const bf16_t* MLK = (const bf16_t*)(p.ws + OFF_MLK);
    const bf16_t* OZ = (const bf16_t*)(p.ws + OFF_OZ); const bf16_t* DNQKV = (const bf16_t*)(p.ws + OFF_DNQKV); const bf16_t* SDZ = (const bf16_t*)(p.ws + OFF_SDZ);
    const float* GATES = (const float*)(p.ws + OFF_GATES); const bf16_t* WK = (const bf16_t*)(p.ws + OFF_WK); const bf16_t* QK = (const bf16_t*)(p.ws + OFF_QK);
    const float* GE = (const float*)(p.ws + OFF_GE); const bf16_t* AB = (const bf16_t*)(p.ws + OFF_MLQ);
    for (size_t i = (size_t)blockIdx.x * 512 + threadIdx.x; i < (size_t)T_TOK * 2048; i += (size_t)gridDim.x * 512) {
        const size_t t = i >> 11; const int c = (int)(i & 2047); float v = 0.f;
#if DBG == 1
        const unsigned pr = ((const unsigned*)p.out)[i];
        v = bf2f(MLV[t * 2048 + c]) + bf2f(OZ[t * 2048 + c]) + bf2f(SDZ[t * 2048 + c]) + bf2f(DNQKV[t * 6144 + c]) + bf2f(DNQKV[t * 6144 + 2048 + c]) + bf2f(DNQKV[t * 6144 + 4096 + c])
          + bf2f(MLQ[t * 1024 + (c & 1023)]) + bf2f(MLK[t * 1024 + (c & 1023)]) + GATES[t * 64 + (c & 63)] + bflo(pr) + bfhi(pr);
#elif DBG == 2
        v = bf2f(DNQKV[t * 6144 + c]) + bf2f(DNQKV[t * 6144 + 2048 + c]) + bf2f(DNQKV[t * 6144 + 4096 + c]) + bf2f(WK[t * 2048 + c]) + bf2f(QK[t * 1024 + (c & 1023)]) + GE[(t >> 6) * 16 + (c & 15)];
#elif DBG == 3
        v = bf2f(MLV[t * 2048 + c]) + bf2f(DNQKV[t * 6144 + 4096 + c]);
#elif DBG == 4
        v = bf2f(MLV[t * 2048 + c]) + bf2f(AB[t * 2048 + c]);
#elif DBG == 5
        v = bf2f(MLV[t * 2048 + c]);
#elif DBG == 6
        v = bf2f(DNQKV[t * 6144 + 4096 + c]);
#endif
        p.out[i] = v;
    }
}
#endif
__global__ void __launch_bounds__(512) hybrid_fwd(Params p) {
    extern __shared__ __attribute__((aligned(16))) unsigned char lds[];
    cg::grid_group grid = cg::this_grid();
    const int lo = p.ph_lo, hi = p.ph_hi;
    volatile LAS unsigned* xst = (volatile LAS unsigned*)((LAS unsigned char*)lds + (LDS_BYTES - 16));
    if (threadIdx.x < 4) xst[threadIdx.x] = 0u;
    __syncthreads();
    XcdBarrier xbar; xbar.bar = (unsigned*)(p.ws + OFF_BAR); xbar.x = 0; xbar.st = xst;
    if (hi - lo > 1) xbar = xcd_barrier_post((unsigned*)(p.ws + OFF_BAR), xst);
#ifndef PH_MASK
#define PH_MASK 127
#endif
#define IN(k) (((PH_MASK >> (k)) & 1) && lo <= (k) && (k) < hi)
#define SEAM(k) do { if (IN(k) && IN((k) + 1)) { if (p.flags == 0x40000000) grid.sync(); else xcd_barrier(xbar); } } while (0)
    if (IN(0)) p0_prologue(p, lds);
    SEAM(0);
    if (IN(1)) {
        pg8::Gemm g{(const pg8::bf16_t*)(p.ws + OFF_U), (const pg8::bf16_t*)(p.ws + OFF_WT), T_TOK, NPAD, 2048};
        SuperTileOrder S{(int)gridDim.x, (int)blockIdx.x};
        EpiProj E{p.ws, (unsigned*)p.out, p.flags};
        pg8::gemm_phase<EpiProj, SuperTileOrder>((PG8_LAS unsigned char*)lds, g, S, E, nullptr);
    }
    SEAM(1);
    if (IN(2)) p2_dnprep(p, lds);
    SEAM(2);
    if (IN(3)) {
#ifndef NO_DN
        if (!(p.flags & 64)) for (int item = blockIdx.x; item < 256; item += gridDim.x) if (item < 128) scan_dn(p, lds, item);
#endif
#ifndef NO_ML
        if (!(p.flags & 128)) for (int item = blockIdx.x; item < 256; item += gridDim.x) if (item >= 128) scan_ml(p, lds, item - 128);
        { const int nml = gridDim.x > 128 ? (int)gridDim.x - 128 : (int)gridDim.x, fml = gridDim.x > 128 ? (int)blockIdx.x - 128 : (int)blockIdx.x;
          if (fml >= 0) p0_transpose(p, lds, (NPAD / 256) * 32, (NPAD / 256) * 32 + 2 * 8 * 32, fml, nml); }
#endif
    }
    SEAM(3);
    if (IN(4)) p4_normgate(p);
    SEAM(4);
    if (IN(5)) {
        pg8::Gemm g{(const pg8::bf16_t*)(p.ws + OFF_MLV), (const pg8::bf16_t*)(p.ws + OFF_WOT), 2 * T_TOK, 4096, 2048};
        OutOrder S; S.so.init(T_TOK, 2048, (int)gridDim.x, (int)blockIdx.x);
        EpiOut E{p.x, p.out, (float*)(p.ws + OFF_ROWSS)};
        pg8::gemm_phase<EpiOut, OutOrder>((PG8_LAS unsigned char*)lds, g, S, E, nullptr);
    }
    SEAM(5);
    if (IN(6)) p6_final(p);
#ifdef EXTRA_SYNCS
    if (hi == 7) { for (int i = 0; i < EXTRA_SYNCS; ++i) grid.sync(); }
#endif
#ifdef DBG
    if (p.ph_lo == 7) p7_debug(p);
#endif
#undef IN
#undef SEAM
}

#ifndef N_LAUNCHES
#define N_LAUNCHES 7
#endif
extern "C" void kernel_launch(void* const* d_in, const int* in_sizes, int n_in, void* d_out, int out_size, void* d_ws, size_t ws_size, hipStream_t stream) {
    static int grid = 0;
    if (grid == 0) {
        if (n_in != 12 || out_size != T_TOK * DM || ws_size < WS_END) { fprintf(stderr, "kernel_launch: bad shapes / workspace (%zu < %zu)\n", ws_size, (size_t)WS_END); grid = -1; return; }
        int dev = 0, cus = 0, per_cu = 0;
        hipGetDevice(&dev); hipDeviceGetAttribute(&cus, hipDeviceAttributeMultiprocessorCount, dev);
        if (hipFuncSetAttribute((const void*)hybrid_fwd, hipFuncAttributeMaxDynamicSharedMemorySize, LDS_BYTES) != hipSuccess) { fprintf(stderr, "hipFuncSetAttribute failed\n"); grid = -1; return; }
        if (hipOccupancyMaxActiveBlocksPerMultiprocessor(&per_cu, (const void*)hybrid_fwd, 512, LDS_BYTES) != hipSuccess || per_cu < 1) { fprintf(stderr, "occupancy query: %d\n", per_cu); per_cu = 1; }
        (void)hipGetLastError();
        grid = cus * 1;
    }
    if (grid < 0) return;
    Params p{};
    p.x = (const float*)d_in[0]; p.norm_w = (const float*)d_in[1]; p.w_in = (const float*)d_in[2]; p.ml_i_bias = (const float*)d_in[3]; p.ml_f_bias = (const float*)d_in[4];
    p.ml_norm_w = (const float*)d_in[5]; p.dn_conv_w = (const float*)d_in[6]; p.dn_a_log = (const float*)d_in[7]; p.dn_dt_bias = (const float*)d_in[8]; p.dn_norm_w = (const float*)d_in[9];
    p.w_out = (const float*)d_in[10]; p.final_norm_w = (const float*)d_in[11]; p.out = (float*)d_out; p.ws = (unsigned char*)d_ws;
#if N_LAUNCHES == 1
    (void)hipMemsetAsync((unsigned char*)d_ws + OFF_BAR, 0, (size_t)XCD_BAR_WORDS * 4, stream);
    void* args[] = {&p};
#ifdef REP_HI
    p.ph_lo = REP_LO; p.ph_hi = REP_HI + 1;
#ifdef REP_FLAGS
    p.flags = REP_FLAGS;
#endif
    (void)hipLaunchCooperativeKernel((const void*)hybrid_fwd, dim3(grid), dim3(512), args, LDS_BYTES, stream);
#endif
#ifdef REP_HI
    (void)hipMemsetAsync((unsigned char*)d_ws + OFF_BAR, 0, (size_t)XCD_BAR_WORDS * 4, stream);
#endif
    p.ph_lo = 0; p.ph_hi = 7; p.flags = 0;
    hipError_t e = hipLaunchCooperativeKernel((const void*)hybrid_fwd, dim3(grid), dim3(512), args, LDS_BYTES, stream);
    if (e != hipSuccess) fprintf(stderr, "cooperative launch failed: %s (grid %d)\n", hipGetErrorString(e), grid);
#else
#ifdef DBG
    const int nph = (DBG == 1) ? 2 : (DBG == 2) ? 3 : (DBG == 4) ? 5 : 4;
    for (int ph = 0; ph < nph; ++ph) { p.ph_lo = ph; p.ph_hi = ph + 1; hipLaunchKernelGGL(hybrid_fwd, dim3(grid), dim3(512), LDS_BYTES, stream, p); }
    p.ph_lo = 7; p.ph_hi = 8; hipLaunchKernelGGL(hybrid_fwd, dim3(grid), dim3(512), LDS_BYTES, stream, p);
#else
    for (int ph = 0; ph < 7; ++ph) { p.ph_lo = ph; p.ph_hi = ph + 1; hipLaunchKernelGGL(hybrid_fwd, dim3(grid), dim3(512), LDS_BYTES, stream, p); }
#endif
#endif
}
```

```cpp
#define N_LAUNCHES 1
#include <hip/hip_runtime.h>
#include <hip/hip_cooperative_groups.h>
#include <cstdio>
namespace cg = cooperative_groups;
#define XB_TMO      128
#define XB_XCNT(j)  (256  + 64 * (j))
#define XB_XSUB(j)  (1280 + 64 * (j))
#define XB_XGEN(j)  (2304 + 64 * (j))
#define XB_TOP      3328
#define XB_TOPGEN   3392
#define XCD_BAR_WORDS 3456
#define XB_SPIN_CAP (1u << 18)
#define LAS __attribute__((address_space(3)))

__device__ __forceinline__ unsigned xb_ld(unsigned* p)              { return __hip_atomic_load(p, __ATOMIC_RELAXED, __HIP_MEMORY_SCOPE_AGENT); }
__device__ __forceinline__ unsigned xb_add(unsigned* p, unsigned v) { return __hip_atomic_fetch_add(p, v, __ATOMIC_RELAXED, __HIP_MEMORY_SCOPE_AGENT); }
__device__ __forceinline__ unsigned xb_xcc_id() { return (unsigned)__builtin_amdgcn_s_getreg((3 << 11) | 20) & 0xFu; }
#define XB_SPIN(cond, bar) do { unsigned _sp = 0; while (cond) { __builtin_amdgcn_s_sleep(1); \
    if ((++_sp & 255u) == 0u) { if (xb_ld(&(bar)[XB_TMO])) break; if (_sp > XB_SPIN_CAP) { atomicAdd(&(bar)[XB_TMO], 1u); break; } } } } while (0)

struct XcdBarrier {
    unsigned* bar; unsigned x;
    volatile LAS unsigned* st;
};

__device__ __forceinline__ XcdBarrier xcd_barrier_post(unsigned* bar, volatile LAS unsigned* st) {
    XcdBarrier b; b.bar = bar; b.x = xb_xcc_id(); b.st = st;
    if (threadIdx.x == 0) (void)xb_add(&bar[XB_XCNT(b.x)], 1u);
    return b;
}
__device__ __forceinline__ void xcd_barrier_complete(unsigned* bar, unsigned x, unsigned& nloc, unsigned& nx) {
    const unsigned G = gridDim.x * gridDim.y * gridDim.z;
    unsigned sum, cnt, mine, sp = 0u;
    for (;;) {
        sum = 0u; cnt = 0u; mine = 0u;
#pragma unroll
        for (unsigned j = 0; j < 16; ++j) { const unsigned c = xb_ld(&bar[XB_XCNT(j)]); sum += c; cnt += (c > 0u) ? 1u : 0u; mine = (j == x) ? c : mine; }
        if (sum == G) break;
        __builtin_amdgcn_s_sleep(1);
        if ((++sp & 255u) == 0u) { if (xb_ld(&bar[XB_TMO])) break; if (sp > XB_SPIN_CAP) { atomicAdd(&bar[XB_TMO], 1u); break; } }
    }
    nloc = mine > 0u ? mine : 1u; nx = cnt > 0u ? cnt : 1u;
}

__device__ __forceinline__ void xcd_barrier(const XcdBarrier& b) {
    asm volatile("s_waitcnt vmcnt(0)" ::: "memory");
    __syncthreads();
    if (threadIdx.x == 0) {
        unsigned* bar = b.bar;
        __builtin_amdgcn_s_waitcnt(0);
        unsigned nloc = b.st[0], nx = b.st[1];
        if (nloc == 0u) { xcd_barrier_complete(bar, b.x, nloc, nx); b.st[0] = nloc; b.st[1] = nx; }
        const unsigned old = xb_add(&bar[XB_XSUB(b.x)], 1u);
        const unsigned gen = old / nloc;
        if (old + 1u == (gen + 1u) * nloc) {
            __builtin_amdgcn_fence(__ATOMIC_RELEASE, "agent");
            asm volatile("s_waitcnt vmcnt(0)" ::: "memory");
            const unsigned og = xb_add(&bar[XB_TOP], 1u);
            const unsigned tg = og / nx;
            if (og + 1u == (tg + 1u) * nx) xb_add(&bar[XB_TOPGEN], 1u);
            else XB_SPIN(xb_ld(&bar[XB_TOPGEN]) == tg, bar);
            __builtin_amdgcn_fence(__ATOMIC_ACQUIRE, "agent");
            xb_add(&bar[XB_XGEN(b.x)], 1u);
            asm volatile("s_waitcnt vmcnt(0)" ::: "memory");
        } else {
            XB_SPIN(xb_ld(&bar[XB_XGEN(b.x)]) == gen, bar);
            __builtin_amdgcn_fence(__ATOMIC_ACQUIRE, "agent");
            asm volatile("s_waitcnt vmcnt(0)" ::: "memory");
        }
    }
    __syncthreads();
}
namespace pg8 {
#define PG8_LAS __attribute__((address_space(3)))
typedef unsigned short bf16_t;
typedef short bf16x8 __attribute__((ext_vector_type(8)));
typedef float f32x4 __attribute__((ext_vector_type(4)));
typedef unsigned u32x4 __attribute__((ext_vector_type(4)));
constexpr int BM = 256, BK = 64, HALF = 128, HTB = HALF * BK * 2  , STAGE_BYTES = 8 * HTB, NXCD = 8, WGM = 8;

__host__ __device__ __forceinline__ int lds_byte(int r, int c) { const int st = (r >> 4) * 2 + (c >> 5), rr = r & 15, cc = c & 31, ob = rr * 64 + cc * 2; return st * 1024 + (ob ^ (((ob >> 9) & 1) << 5)); }
__host__ __device__ __forceinline__ void stage_rc(int b, int& R, int& C) { const int st = b / 1024, sb = b % 1024, swz = sb ^ (((sb >> 9) & 1) << 5); R = (st >> 1) * 16 + swz / 64; C = (st & 1) * 32 + (swz % 64) / 2; }
__host__ __device__ __forceinline__ int perm32(int rho) { const int n = rho >> 4, i = rho & 15; return 8 * (i >> 2) + 4 * n + (i & 3); }

struct Unit { int pm, pn; };
struct Gemm { const bf16_t* A; const bf16_t* Bt; int M, N, K; };

struct StaticOrder {
    int nM, nN, nwg, G, c;
    __host__ __device__ void init(int M, int N, int G_, int c_) { nM = M / BM; nN = N / BM; nwg = nM * nN; G = G_; c = c_; }
    __host__ __device__ bool next(int i, Unit& u) const {
        const long L = (long)i * G + c; if (L >= nwg) return false;
        int wgid = (int)L; { const int q = nwg / NXCD, r = nwg % NXCD, xcd = wgid % NXCD, off = wgid / NXCD; wgid = (xcd < r ? xcd * (q + 1) : r * (q + 1) + (xcd - r) * q) + off; }
        const int nig = WGM * nN, gid = wgid / nig, fm = gid * WGM, gsz = (nM - fm) < WGM ? (nM - fm) : WGM;
        u.pm = fm + ((wgid % nig) % gsz); u.pn = (wgid % nig) / gsz; return true;
    }
    __device__ __forceinline__ void a_ready(const Unit&) const {}
    __device__ __forceinline__ void done(const Unit&) const {}
};
__device__ __forceinline__ unsigned cvt_pk_bf16(float lo, float hi) { unsigned r; asm volatile("v_cvt_pk_bf16_f32 %0, %1, %2" : "=v"(r) : "v"(lo), "v"(hi)); return r; }
template <class Epi, class Sched, bool STAMP = false>
__device__ __forceinline__ void gemm_phase(PG8_LAS unsigned char* lds, const Gemm g, const Sched& S, const Epi& E, unsigned long long* stamps) {
    const int tid = threadIdx.x, wid = __builtin_amdgcn_readfirstlane(tid >> 6), lane = tid & 63, wr = wid >> 2, wc = wid & 3, fr = lane & 15, fq = lane >> 4;
    const int K = g.K, nt = K / BK;
    int ts_lo = 0, ts_hi = 0, nts = 0; const unsigned long long rt_entry = STAMP ? (unsigned long long)wall_clock64() : 0ull;
#define PG8_STAMP() do { if (STAMP && wid == 0 && nts < 64) { const unsigned long long _c = (unsigned long long)clock64(); \
        ts_lo = (lane == nts) ? (int)(unsigned)_c : ts_lo; ts_hi = (lane == nts) ? (int)(unsigned)(_c >> 32) : ts_hi; ++nts; } } while (0)
    PG8_STAMP();
    unsigned voffA[2], voffB[2];
#pragma unroll
    for (int i = 0; i < 2; ++i) { int R, C; stage_rc(tid * 16 + i * 8192, R, C); const int Rb = Epi::PERM ? ((R & ~31) + perm32(R & 31)) : R;
        voffA[i] = (unsigned)(R * K + C) * 2u; voffB[i] = (unsigned)(Rb * K + C) * 2u; }
    const size_t kstep = (size_t)(BK * 2);
    const size_t hstep = (size_t)HALF * K * 2;
    const size_t tstep = 2 * hstep;
    const unsigned ldsw = (unsigned)wid * 1024u;
    const int aoff = lds_byte(wr * 64 + fr, fq * 8), boff = lds_byte(wc * 32 + fr, fq * 8);
#define PG8_SA(b, h) (((b) * 2 + (h)) * HTB)
#define PG8_SB(b, h) ((4 + (b) * 2 + (h)) * HTB)
#define PG8_STAGE(bufoff, gbase, voff) do { _Pragma("unroll") for (int _i = 0; _i < 2; ++_i) \
        __builtin_amdgcn_global_load_lds((const unsigned*)((const char*)(gbase) + (voff)[_i]), (PG8_LAS unsigned*)(lds + (bufoff) + ldsw + _i * 8192), 16, 0, 0); } while (0)
#define PG8_LDA(dst, b, h) do { _Pragma("unroll") for (int m = 0; m < 4; ++m) _Pragma("unroll") for (int k = 0; k < 2; ++k) dst[m][k] = *(const PG8_LAS bf16x8*)(lds + PG8_SA(b, h) + aoff + m * 2048 + k * 1024); } while (0)
#define PG8_LDB(dst, b, h) do { _Pragma("unroll") for (int n = 0; n < 2; ++n) _Pragma("unroll") for (int k = 0; k < 2; ++k) dst[n][k] = *(const PG8_LAS bf16x8*)(lds + PG8_SB(b, h) + boff + n * 2048 + k * 1024); } while (0)
#define PG8_MMA(ai, bj, At, Bt) do { __builtin_amdgcn_s_setprio(1); _Pragma("unroll") for (int m = 0; m < 4; ++m) _Pragma("unroll") for (int n = 0; n < 2; ++n) _Pragma("unroll") for (int k = 0; k < 2; ++k) \
        acc[ai][bj][m][n] = __builtin_amdgcn_mfma_f32_16x16x32_bf16(Bt[n][k], At[m][k], acc[ai][bj][m][n], 0, 0, 0); __builtin_amdgcn_s_setprio(0); } while (0)
#define PG8_WAIT_V(n) asm volatile("s_waitcnt vmcnt(" #n ")" ::: "memory")
#define PG8_WAIT_L(n) asm volatile("s_waitcnt lgkmcnt(" #n ")" ::: "memory")
#define PG8_BAR __builtin_amdgcn_s_barrier()
#define PG8_SCHED __builtin_amdgcn_sched_barrier(0)
    Unit cur, nxt; int ui = 0;
    if (!S.next(0, cur)) return;
    f32x4 acc[2][2][4][2];
#pragma unroll
    for (int a = 0; a < 2; ++a)
#pragma unroll
        for (int b = 0; b < 2; ++b)
#pragma unroll
            for (int m = 0; m < 4; ++m)
#pragma unroll
                for (int n = 0; n < 2; ++n) acc[a][b][m][n] = (f32x4){0.f, 0.f, 0.f, 0.f};
    bf16x8 At[4][2], B0[2][2], B1[2][2];
    const char* cA = (const char*)g.A + (size_t)cur.pm * tstep; const char* cB = (const char*)g.Bt + (size_t)cur.pn * tstep;
    S.a_ready(cur);
    PG8_STAGE(PG8_SB(0, 0), cB, voffB); PG8_STAGE(PG8_SA(0, 0), cA, voffA); PG8_STAGE(PG8_SB(0, 1), cB + hstep, voffB); PG8_STAGE(PG8_SA(0, 1), cA + hstep, voffA);
    if (wr == 1) PG8_BAR;
    PG8_WAIT_V(4); PG8_BAR;
    PG8_STAGE(PG8_SB(1, 0), cB + kstep, voffB); PG8_STAGE(PG8_SA(1, 0), cA + kstep, voffA); PG8_STAGE(PG8_SB(1, 1), cB + hstep + kstep, voffB);
    PG8_WAIT_V(6); PG8_BAR;
    PG8_STAMP();
    for (;;) {
        const bool has_next = S.next(ui + 1, nxt);
        const char* nA = has_next ? (const char*)g.A + (size_t)nxt.pm * tstep : cA; const char* nB = has_next ? (const char*)g.Bt + (size_t)nxt.pn * tstep : cB;
        for (int t = 0; t < nt; t += 2) {
            const bool last = (t == nt - 2);
            const char* a1 = cA + (size_t)(t + 1) * kstep;
            const char* a2 = last ? nA : cA + (size_t)(t + 2) * kstep; const char* b2 = last ? nB : cB + (size_t)(t + 2) * kstep;
            const char* a3 = a2 + kstep; const char* b3 = b2 + kstep;
            if (last && has_next) S.a_ready(nxt);
            PG8_LDB(B0, 0, 0); PG8_SCHED; PG8_LDA(At, 0, 0); PG8_STAGE(PG8_SA(1, 1), a1 + hstep, voffA);
            PG8_WAIT_L(8); PG8_BAR; PG8_WAIT_L(0); PG8_MMA(0, 0, At, B0); PG8_BAR; PG8_SCHED;
            PG8_LDB(B1, 0, 1); PG8_STAGE(PG8_SB(0, 0), b2, voffB);
            PG8_BAR; PG8_WAIT_L(0); PG8_MMA(0, 1, At, B1); PG8_BAR;
            PG8_LDA(At, 0, 1); PG8_STAGE(PG8_SA(0, 0), a2, voffA);
            PG8_BAR; PG8_WAIT_L(0); PG8_MMA(1, 0, At, B0); PG8_BAR; PG8_SCHED;
            PG8_STAGE(PG8_SB(0, 1), b2 + hstep, voffB);
            PG8_WAIT_V(6); PG8_BAR; PG8_MMA(1, 1, At, B1); PG8_BAR;
            PG8_LDB(B0, 1, 0); PG8_SCHED; PG8_LDA(At, 1, 0); PG8_STAGE(PG8_SA(0, 1), a2 + hstep, voffA);
            PG8_WAIT_L(8); PG8_BAR; PG8_WAIT_L(0); PG8_MMA(0, 0, At, B0); PG8_BAR; PG8_SCHED;
            PG8_LDB(B1, 1, 1); PG8_STAGE(PG8_SB(1, 0), b3, voffB);
            PG8_BAR; PG8_WAIT_L(0); PG8_MMA(0, 1, At, B1); PG8_BAR;
            PG8_LDA(At, 1, 1); PG8_STAGE(PG8_SA(1, 0), a3, voffA);
            PG8_BAR; PG8_WAIT_L(0); PG8_MMA(1, 0, At, B0); PG8_BAR; PG8_SCHED;
            PG8_STAGE(PG8_SB(1, 1), b3 + hstep, voffB);
            PG8_WAIT_V(6); PG8_BAR; PG8_MMA(1, 1, At, B1); PG8_BAR;
        }
        PG8_STAMP();
        bool keep_acc = false;
        if constexpr (!Epi::AFTER_DRAIN) { keep_acc = E(acc, cur, wr, wc, fr, fq); S.done(cur); }
        PG8_STAMP();
        if (!has_next) break;
        if (!keep_acc)
#pragma unroll
        for (int a = 0; a < 2; ++a)
#pragma unroll
            for (int b = 0; b < 2; ++b)
#pragma unroll
                for (int m = 0; m < 4; ++m)
#pragma unroll
                    for (int n = 0; n < 2; ++n) acc[a][b][m][n] = (f32x4){0.f, 0.f, 0.f, 0.f};
        cur = nxt; cA = nA; cB = nB; ++ui;
    }
    PG8_WAIT_V(0);
    if (wr == 0) PG8_BAR;
    PG8_BAR;
    if constexpr (Epi::AFTER_DRAIN) { E.fused(acc, cur, wr, wc, fr, fq, lds, wid, lane); S.done(cur); }
    PG8_STAMP();
    if (STAMP && wid == 0) { stamps[lane] = lane < nts ? (((unsigned long long)(unsigned)ts_hi << 32) | (unsigned)ts_lo) : 0ull;
        if (lane == 62) stamps[62] = rt_entry; if (lane == 63) stamps[63] = (unsigned long long)wall_clock64(); }
#undef PG8_STAMP
#undef PG8_SA
#undef PG8_SB
#undef PG8_STAGE
#undef PG8_LDA
#undef PG8_LDB
#undef PG8_MMA
#undef PG8_WAIT_V
#undef PG8_WAIT_L
#undef PG8_BAR
#undef PG8_SCHED
}
}

#define DI __device__ __forceinline__
typedef unsigned short bf16_t;
typedef short bf16x8 __attribute__((ext_vector_type(8)));
typedef float f32x4 __attribute__((ext_vector_type(4)));
typedef unsigned u32x4 __attribute__((ext_vector_type(4)));
typedef unsigned u32x2 __attribute__((ext_vector_type(2)));

constexpr int T_TOK = 16384, DM = 2048, IN_DIM = 20528, NPAD = 20736;
constexpr int LDS_BYTES = 152 * 1024;
constexpr float EPS = 1e-6f;

constexpr size_t SZ_T2048 = (size_t)T_TOK * 2048 * 2;
constexpr size_t OFF_WT = 0;
constexpr size_t OFF_QK = 0;
constexpr size_t OFF_U = OFF_WT + (size_t)NPAD * 2048 * 2;
constexpr size_t OFF_WK = OFF_U;
constexpr size_t OFF_MLV = OFF_U + SZ_T2048;
constexpr size_t OFF_MLQ = OFF_MLV + SZ_T2048;
constexpr size_t OFF_MLK = OFF_MLQ + SZ_T2048 / 2;
constexpr size_t OFF_OZ = OFF_MLK + SZ_T2048 / 2;
constexpr size_t OFF_DNQKV = OFF_OZ + SZ_T2048;
constexpr size_t OFF_PBUF = OFF_DNQKV;
constexpr size_t OFF_SDZ = OFF_DNQKV + 3 * SZ_T2048;
constexpr size_t OFF_GATES = OFF_SDZ + SZ_T2048;
constexpr size_t OFF_HALO = OFF_GATES + (size_t)T_TOK * 64 * 4;
constexpr size_t OFF_WOT = OFF_HALO + (size_t)256 * 3 * 6144 * 2;
constexpr size_t OFF_ROWSS = OFF_WOT + (size_t)2 * 2048 * 2048 * 2;
constexpr size_t OFF_GE = OFF_ROWSS + (size_t)T_TOK * 4;
constexpr size_t OFF_BAR = OFF_GE + 4096 * 4;
constexpr size_t WS_END = OFF_BAR + (size_t)XCD_BAR_WORDS * 4;

struct Params {
    const float *x, *norm_w, *w_in, *ml_i_bias, *ml_f_bias, *ml_norm_w, *dn_conv_w, *dn_a_log, *dn_dt_bias, *dn_norm_w, *w_out, *final_norm_w;
    float* out; unsigned char* ws; int ph_lo, ph_hi; int flags, pad;
};

typedef __bf16 bf16x2_t __attribute__((ext_vector_type(2)));
typedef float f32x2_t __attribute__((ext_vector_type(2)));
DI unsigned pk(float lo, float hi) { const f32x2_t v = {lo, hi}; const bf16x2_t b = __builtin_convertvector(v, bf16x2_t); return __builtin_bit_cast(unsigned, b); }
DI bf16_t f2bf(float f) { return (bf16_t)(pk(f, 0.f) & 0xffffu); }
DI float bf2f(bf16_t b) { return __uint_as_float(((unsigned)b) << 16); }
DI float bflo(unsigned u) { return __uint_as_float(u << 16); }
DI float bfhi(unsigned u) { return __uint_as_float(u & 0xffff0000u); }
DI float sigmoidf_(float x) { return __fdividef(1.f, 1.f + __expf(-x)); }
DI float softplusf_(float x) { return fmaxf(x, 0.f) + log1pf(__expf(-fabsf(x))); }
DI float softcapf_(float x) { return 15.f * tanhf(x * (1.f / 15.f)); }
#define DPPF(old, src, ctrl, rm) __int_as_float(__builtin_amdgcn_update_dpp(__float_as_int(old), __float_as_int(src), (ctrl), (rm), 0xF, false))
DI float dpp_incl_sum(float v) {
    v += DPPF(0.f, v, 0x111, 0xF); v += DPPF(0.f, v, 0x112, 0xF); v += DPPF(0.f, v, 0x114, 0xF); v += DPPF(0.f, v, 0x118, 0xF);
    v += DPPF(0.f, v, 0x142, 0xA); v += DPPF(0.f, v, 0x143, 0xC); return v;
}
DI float dpp_incl_max(float v) {
    const float ninf = -__builtin_huge_valf();
    v = fmaxf(v, DPPF(ninf, v, 0x111, 0xF)); v = fmaxf(v, DPPF(ninf, v, 0x112, 0xF)); v = fmaxf(v, DPPF(ninf, v, 0x114, 0xF)); v = fmaxf(v, DPPF(ninf, v, 0x118, 0xF));
    v = fmaxf(v, DPPF(ninf, v, 0x142, 0xA)); v = fmaxf(v, DPPF(ninf, v, 0x143, 0xC)); return v;
}
DI float fexp(float x) { return __builtin_amdgcn_exp2f(1.4426950408889634f * x); }
DI float flog1pexp_negabs(float x) { return 0.6931471805599453f * __builtin_amdgcn_logf(1.f + __builtin_amdgcn_exp2f(-1.4426950408889634f * fabsf(x))); }
DI float fsoftcap(float x) { const float e = __builtin_amdgcn_exp2f(x * (-2.f * 1.4426950408889634f / 15.f)); return 15.f * (1.f - e) * __builtin_amdgcn_rcpf(1.f + e); }
DI float wave_sum(float v) { for (int d = 32; d >= 1; d >>= 1) v += __shfl_xor(v, d); return v; }
DI float wave_incl_sum(float v, int lane) { for (int d = 1; d < 64; d <<= 1) { float o = __shfl_up(v, d); if (lane >= d) v += o; } return v; }
DI float wave_incl_max(float v, int lane) { for (int d = 1; d < 64; d <<= 1) { float o = __shfl_up(v, d); if (lane >= d) v = fmaxf(v, o); } return v; }
DI void lds_bar() { asm volatile("s_waitcnt lgkmcnt(0)" ::: "memory"); __builtin_amdgcn_s_barrier(); asm volatile("" ::: "memory"); }
DI float row16_sum(float v) {
    v += __int_as_float(__builtin_amdgcn_update_dpp(0, __float_as_int(v), 0xB1, 0xF, 0xF, true));
    v += __int_as_float(__builtin_amdgcn_update_dpp(0, __float_as_int(v), 0x4E, 0xF, 0xF, true));
    v += __int_as_float(__builtin_amdgcn_update_dpp(0, __float_as_int(v), 0x124, 0xF, 0xF, true));
    v += __int_as_float(__builtin_amdgcn_update_dpp(0, __float_as_int(v), 0x128, 0xF, 0xF, true));
    return v;
}
DI float fast_sigmoid(float x) { return __builtin_amdgcn_rcpf(1.f + __builtin_amdgcn_exp2f(-1.4426950408889634f * x)); }
DI void unpack8(const u32x4& r, float (&f)[8]) {
#pragma unroll
    for (int e = 0; e < 4; ++e) { f[2 * e] = bflo(r[e]); f[2 * e + 1] = bfhi(r[e]); }
}
DI u32x4 pack8(const float (&f)[8]) { u32x4 r; r.x = pk(f[0], f[1]); r.y = pk(f[2], f[3]); r.z = pk(f[4], f[5]); r.w = pk(f[6], f[7]); return r; }

template <int KS> DI void mma16(f32x4& acc, const bf16_t* A, int lda, int arow0, const bf16_t* Bt, int ldb, int brow0, int lane) {
    const int r = lane & 15, q = lane >> 4;
    const bf16_t* ap = A + (arow0 + r) * lda + q * 8;
    const bf16_t* bp = Bt + (brow0 + r) * ldb + q * 8;
#pragma unroll
    for (int ks = 0; ks < KS; ++ks) {
        const bf16x8 a = *(const bf16x8*)(ap + ks * 32), b = *(const bf16x8*)(bp + ks * 32);
        acc = __builtin_amdgcn_mfma_f32_16x16x32_bf16(a, b, acc, 0, 0, 0);
    }
}

template <int KS> DI void lda16(bf16x8 (&af)[KS], const bf16_t* A, int lda, int arow0, int lane) {
    const bf16_t* ap = A + (arow0 + (lane & 15)) * lda + (lane >> 4) * 8;
#pragma unroll
    for (int ks = 0; ks < KS; ++ks) af[ks] = *(const bf16x8*)(ap + ks * 32);
}
template <int KS> DI void mma16r(f32x4& acc, const bf16x8 (&af)[KS], const bf16_t* Bt, int ldb, int brow0, int lane) {
    const bf16_t* bp = Bt + (brow0 + (lane & 15)) * ldb + (lane >> 4) * 8;
#pragma unroll
    for (int ks = 0; ks < KS; ++ks) { const bf16x8 b = *(const bf16x8*)(bp + ks * 32); acc = __builtin_amdgcn_mfma_f32_16x16x32_bf16(af[ks], b, acc, 0, 0, 0); }
}
template <int KS> DI void mma16rT(f32x4& acc, const bf16x8 (&af)[KS], const bf16_t* Bt, int ldb, int brow0, int lane) {
    const bf16_t* bp = Bt + (brow0 + (lane & 15)) * ldb + (lane >> 4) * 8;
#pragma unroll
    for (int ks = 0; ks < KS; ++ks) { const bf16x8 b = *(const bf16x8*)(bp + ks * 32); acc = __builtin_amdgcn_mfma_f32_16x16x32_bf16(b, af[ks], acc, 0, 0, 0); }
}
DI int src_col(int np) {
    if (np < 4096) return np;
    if (np < 8192) { const int j = (np - 4096) >> 8, r = (np - 4096) & 255; return r < 128 ? 4096 + 128 * j + r : 6144 + 128 * j + (r - 128); }
    if (np < 14336) return 8208 + (np - 8192);
    if (np < 16384) return 14352 + (np - 14336);
    if (np < 20480) { const int j = (np - 16384) >> 8, r = (np - 16384) & 255; return r < 128 ? 16432 + 128 * j + r : 18480 + 128 * j + (r - 128); }
    if (np < 20496) return 8192 + (np - 20480);
    if (np < 20528) return 16400 + (np - 20496);
    return -1;
}

DI void p0_transpose(const Params& p, unsigned char* lds, int t_lo, int t_hi, int first, int stride) {
    const int tid = threadIdx.x;
    float* tile = (float*)lds;
    constexpr int NT_IN = (NPAD / 256) * 32;
    bf16_t* Wt = (bf16_t*)(p.ws + OFF_WT); bf16_t* WoT = (bf16_t*)(p.ws + OFF_WOT);
    const int g4 = tid & 63, kr = tid >> 6;
#pragma unroll 1
    for (int tix = t_lo + first; tix < t_hi; tix += stride) {
        const float* src; size_t ld; int sc, k0; bf16_t* dst;
        if (tix < NT_IN) { const int ntile = tix >> 5, kt = tix & 31; k0 = kt * 64; sc = src_col(ntile * 256 + g4 * 4); src = p.w_in; ld = IN_DIM; dst = Wt + (size_t)ntile * 256 * 2048; }
        else { const int r = tix - NT_IN, half = r >> 8, r2 = r & 255, ntile = r2 >> 5, kt = r2 & 31; k0 = kt * 64; sc = ntile * 256 + g4 * 4; src = p.w_out + (size_t)half * 2048 * 2048; ld = 2048; dst = WoT + (size_t)half * 2048 * 2048 + (size_t)ntile * 256 * 2048; }
        f32x4 v[8];
#pragma unroll
        for (int i = 0; i < 8; ++i) v[i] = sc >= 0 ? *(const f32x4*)(src + (size_t)(k0 + i * 8 + kr) * ld + sc) : (f32x4){0.f, 0.f, 0.f, 0.f};
#pragma unroll
        for (int i = 0; i < 8; ++i) *(f32x4*)(tile + (i * 8 + kr) * 260 + g4 * 4) = v[i];
        lds_bar();
#pragma unroll
        for (int it = 0; it < 4; ++it) { const int piece = it * 512 + tid, k8 = piece >> 8, n = piece & 255; float f[8];
#pragma unroll
            for (int i = 0; i < 8; ++i) f[i] = tile[(k8 * 8 + i) * 260 + n];
            *(u32x4*)(dst + (size_t)n * 2048 + k0 + k8 * 8) = pack8(f); }
        lds_bar();
    }
}

DI void p0_prologue(const Params& p, unsigned char* lds) {
    const int tid = threadIdx.x, lane = tid & 63, wid = tid >> 6;
    float* rowss = (float*)(p.ws + OFF_ROWSS);
    for (int i = blockIdx.x * 512 + tid; i < T_TOK; i += gridDim.x * 512) rowss[i] = 0.f;
    bf16_t* U = (bf16_t*)(p.ws + OFF_U);
    const int rstep = gridDim.x * 8;
#pragma unroll 1
    for (int row = blockIdx.x * 8 + wid; row < T_TOK; row += 2 * rstep) {
        const int row2 = (row + rstep < T_TOK) ? row + rstep : row;
        const float4* xa = (const float4*)(p.x + (size_t)row * DM); const float4* xb = (const float4*)(p.x + (size_t)row2 * DM);
        float4 va[8], vb[8]; float sa = 0.f, sb = 0.f;
#pragma unroll
        for (int i = 0; i < 8; ++i) { va[i] = xa[i * 64 + lane]; vb[i] = xb[i * 64 + lane]; }
#pragma unroll
        for (int i = 0; i < 8; ++i) { sa += va[i].x * va[i].x + va[i].y * va[i].y + va[i].z * va[i].z + va[i].w * va[i].w; sb += vb[i].x * vb[i].x + vb[i].y * vb[i].y + vb[i].z * vb[i].z + vb[i].w * vb[i].w; }
        sa = wave_sum(sa); sb = wave_sum(sb);
        const float ra = rsqrtf(sa * (1.f / 2048.f) + EPS), rb = rsqrtf(sb * (1.f / 2048.f) + EPS);
#pragma unroll
        for (int i = 0; i < 8; ++i) { const float4 w = ((const float4*)p.norm_w)[i * 64 + lane];
            u32x2 o; o.x = pk(va[i].x * ra * w.x, va[i].y * ra * w.y); o.y = pk(va[i].z * ra * w.z, va[i].w * ra * w.w);
            *(u32x2*)(U + (size_t)row * DM + (i * 64 + lane) * 4) = o;
            u32x2 o2; o2.x = pk(vb[i].x * rb * w.x, vb[i].y * rb * w.y); o2.y = pk(vb[i].z * rb * w.z, vb[i].w * rb * w.w);
            *(u32x2*)(U + (size_t)row2 * DM + (i * 64 + lane) * 4) = o2; }
    }
    p0_transpose(p, lds, 0, (NPAD / 256) * 32, blockIdx.x, gridDim.x);
}

struct EpiProj {
    static constexpr bool PERM = true, AFTER_DRAIN = false;
    unsigned char* ws; unsigned* dout; int flags;
    DI bool operator()(const f32x4 (&acc)[2][2][4][2], const pg8::Unit& u, int wr, int wc, int fr, int fq) const {
        if (flags & 256) return false;
        const int pn = u.pn;
        const int row0 = u.pm * 256 + wr * 64 + fr;
        const int lc = wc * 32 + 8 * fq;
        if (pn < 16 || (pn >= 32 && pn < 56)) {
            bf16_t* base; int ldc, colt; float sc = 1.f; bool halo = false;
            if (pn < 4) { base = (bf16_t*)(ws + OFF_MLQ); ldc = 1024; colt = pn * 256; sc = 0.08838834764831845f; }
            else if (pn < 8) { base = (bf16_t*)(ws + OFF_MLK); ldc = 1024; colt = (pn - 4) * 256; }
            else if (pn < 16) { base = (bf16_t*)(ws + OFF_MLV); ldc = 2048; colt = (pn - 8) * 256; }
            else { base = (bf16_t*)(ws + OFF_DNQKV); ldc = 6144; colt = (pn - 32) * 256; halo = true; }
            bf16_t* hb = (bf16_t*)(ws + OFF_HALO);
#pragma unroll
            for (int ai = 0; ai < 2; ++ai)
#pragma unroll
                for (int m = 0; m < 4; ++m) { const int row = row0 + ai * 128 + m * 16; bf16_t* rowp = base + (size_t)row * ldc + colt + lc;
#pragma unroll
                    for (int bj = 0; bj < 2; ++bj) { const f32x4 v0 = acc[ai][bj][m][0] * sc, v1 = acc[ai][bj][m][1] * sc;
                        u32x4 w; w.x = pk(v0[0], v0[1]); w.y = pk(v0[2], v0[3]); w.z = pk(v1[0], v1[1]); w.w = pk(v1[2], v1[3]);
                        *(u32x4*)(rowp + bj * 128) = w;
                        if (halo && (row & 63) >= 61) *(u32x4*)(hb + ((size_t)(row >> 6) * 3 + ((row & 63) - 61)) * 6144 + colt + lc + bj * 128) = w; } }
        } else if (pn < 32) {
            bf16_t* base = (bf16_t*)(ws + OFF_OZ) + (pn - 16) * 128 + lc;
#pragma unroll
            for (int ai = 0; ai < 2; ++ai)
#pragma unroll
                for (int m = 0; m < 4; ++m) { const int row = row0 + ai * 128 + m * 16; float f[8];
#pragma unroll
                    for (int n = 0; n < 2; ++n)
#pragma unroll
                        for (int i = 0; i < 4; ++i) { const float o = acc[ai][0][m][n][i], z = acc[ai][1][m][n][i];
                            const float eo = __builtin_amdgcn_exp2f(-1.4426950408889634f * o), ez = __builtin_amdgcn_exp2f(-1.4426950408889634f * z); f[n * 4 + i] = z * __builtin_amdgcn_rcpf((1.f + eo) * (1.f + ez)); }
                    *(u32x4*)(base + (size_t)row * 2048) = pack8(f); }
        } else if (pn < 64) {
            bf16_t* base = (bf16_t*)(ws + OFF_SDZ) + (pn - 56) * 256 + lc;
#pragma unroll
            for (int ai = 0; ai < 2; ++ai)
#pragma unroll
                for (int m = 0; m < 4; ++m) { const int row = row0 + ai * 128 + m * 16;
#pragma unroll
                    for (int bj = 0; bj < 2; ++bj) { float f[8];
#pragma unroll
                        for (int n = 0; n < 2; ++n)
#pragma unroll
                            for (int i = 0; i < 4; ++i) { const float z = acc[ai][bj][m][n][i]; f[n * 4 + i] = z * fast_sigmoid(z); }
                        *(u32x4*)(base + (size_t)row * 2048 + bj * 128) = pack8(f); } }
        } else if (pn < 80) {
            unsigned* base = dout + (pn - 64) * 128 + lc;
#pragma unroll
            for (int ai = 0; ai < 2; ++ai)
#pragma unroll
                for (int m = 0; m < 4; ++m) { const int row = row0 + ai * 128 + m * 16;
#pragma unroll
                    for (int n = 0; n < 2; ++n) { u32x4 w;
#pragma unroll
                        for (int i = 0; i < 4; ++i) { const float ea = __builtin_amdgcn_exp2f(-1.4426950408889634f * acc[ai][0][m][n][i]), eb = __builtin_amdgcn_exp2f(-1.4426950408889634f * acc[ai][1][m][n][i]);
                            const float hb = fminf(1.f + eb, 1e30f);
                            w[i] = pk(__builtin_amdgcn_rcpf(1.f + ea) * hb, hb); }
                        *(u32x4*)(base + (size_t)row * 2048 + 4 * n) = w; } }
        } else {
            if (wc < 2) { float* base = (float*)(ws + OFF_GATES) + lc;
#pragma unroll
                for (int ai = 0; ai < 2; ++ai)
#pragma unroll
                    for (int m = 0; m < 4; ++m) { const int row = row0 + ai * 128 + m * 16;
#pragma unroll
                        for (int n = 0; n < 2; ++n) *(f32x4*)(base + (size_t)row * 64 + 4 * n) = acc[ai][0][m][n]; } }
        }
        return false;
    }
};

struct SuperTileOrder {
    int G, c;
    DI bool next(int i, pg8::Unit& u) const {
        if (G != 256) { const long L = (long)i * G + c; if (L >= 64 * 81) return false; u.pm = (int)(L % 64); u.pn = (int)(L / 64); return true; }
        const int x = c & 7, j = c >> 3;
        if (i < 20) { const int R = i / 5, Cc = i - R * 5; u.pm = R * 16 + (x & 1) * 8 + (j & 7); u.pn = Cc * 16 + (x >> 1) * 4 + (j >> 3); return true; }
        if (i == 20 && j < 8) { u.pm = x * 8 + j; u.pn = 80; return true; }
        return false;
    }
    DI void a_ready(const pg8::Unit&) const {}
    DI void done(const pg8::Unit&) const {}
};
constexpr int A_B_TILE_OFS = (int)((OFF_SDZ - OFF_MLV) / ((size_t)256 * 2048 * 2));
static_assert((OFF_SDZ - OFF_MLV) % ((size_t)256 * 2048 * 2) == 0, "A_b must sit a whole number of 256-row tiles after A_a");
struct EpiOut {
    static constexpr bool PERM = false, AFTER_DRAIN = false;
    const float* x; float* out; float* rowss;
    DI bool operator()(f32x4 (&acc)[2][2][4][2], const pg8::Unit& u, int wr, int wc, int fr, int fq) const {
        const bool half = u.pm >= 64; const int pm = half ? u.pm - A_B_TILE_OFS : u.pm, pn = u.pn & 7;
        const int row0 = pm * 256 + wr * 64 + fr, col0 = pn * 256 + wc * 32 + 4 * fq;
#pragma unroll
        for (int ai = 0; ai < 2; ++ai)
#pragma unroll
            for (int m = 0; m < 4; ++m) { const int row = row0 + ai * 128 + m * 16; const size_t off = (size_t)row * 2048 + col0; float ss = 0.f;
#pragma unroll
                for (int bj = 0; bj < 2; ++bj)
#pragma unroll
                    for (int n = 0; n < 2; ++n) { const size_t o = off + bj * 128 + n * 16; const u32x4 pr = *(const u32x4*)((const unsigned*)out + o);
                        if (!half) { f32x4 r; r[0] = bflo(pr[0]); r[1] = bflo(pr[1]); r[2] = bflo(pr[2]); r[3] = bflo(pr[3]);
                            acc[ai][bj][m][n] *= r; }
                        else { f32x4 gb; gb[0] = __builtin_amdgcn_rcpf(bfhi(pr[0])); gb[1] = __builtin_amdgcn_rcpf(bfhi(pr[1])); gb[2] = __builtin_amdgcn_rcpf(bfhi(pr[2])); gb[3] = __builtin_amdgcn_rcpf(bfhi(pr[3]));
                            const f32x4 xv = *(const f32x4*)(x + o); const f32x4 hh = xv + gb * acc[ai][bj][m][n];
                            *(f32x4*)(out + o) = hh; ss += hh[0] * hh[0] + hh[1] * hh[1] + hh[2] * hh[2] + hh[3] * hh[3]; } }
                if (half) { ss += __shfl_xor(ss, 16); ss += __shfl_xor(ss, 32); if (fq == 0) atomicAdd(rowss + row, ss); }
                asm volatile("" ::: "memory"); }
        return !half;
    }
};
struct OutOrder {
    pg8::StaticOrder so;
    DI bool next(int i, pg8::Unit& u) const { pg8::Unit t; const int half = i & 1;
        if (so.G == 256) {
            const int ti = i >> 1; if (ti >= 2) return false; const int x = so.c & 7, j = so.c >> 3; t.pm = ti * 32 + x * 4 + (j & 3); t.pn = j >> 2; }
        else if (!so.next(i >> 1, t)) return false;
        u.pm = t.pm + A_B_TILE_OFS * half; u.pn = t.pn + 8 * half; return true; }
    DI void a_ready(const pg8::Unit&) const {}
    DI void done(const pg8::Unit&) const {}
};

DI void p2_dnprep(const Params& p, unsigned char* lds) {
    const int tid = threadIdx.x, lane = tid & 63, wid = tid >> 6, q = lane >> 4, cl = lane & 15;
    bf16_t* sraw = (bf16_t*)lds;
    float* sR = (float*)lds;
    bf16_t* sqn = (bf16_t*)(lds + 52736);
    bf16_t* skn = sqn + 64 * 136;
    bf16_t* svn = skn + 64 * 136;
    float* sA = (float*)(lds + 104960);
    float* sbeta = (float*)(lds + 125440);
    float* sgam = sbeta + 64; float* sbg = sgam + 64;
    float* scw = (float*)(lds + 126208);
    float* sT = (float*)(lds + 132352);
    bf16_t* DNQKV = (bf16_t*)(p.ws + OFF_DNQKV); const bf16_t* HALO = (const bf16_t*)(p.ws + OFF_HALO);
    const float* GATES = (const float*)(p.ws + OFF_GATES); bf16_t* WK = (bf16_t*)(p.ws + OFF_WK); bf16_t* QK = (bf16_t*)(p.ws + OFF_QK);
    float* GE = (float*)(p.ws + OFF_GE);
    const int h = blockIdx.x & 15, bstep = gridDim.x >> 4;
    for (int i = tid; i < 1536; i += 512) { const int j = i / 384, r = i - j * 384, which = r >> 7, c = r & 127; scw[i] = p.dn_conv_w[(size_t)j * 6144 + which * 2048 + h * 128 + c]; }
    const float alog = -__expf(p.dn_a_log[h]), dtb = p.dn_dt_bias[h];
    u32x4 pre[7]; float pgb = 0.f, pga = 0.f;
#define P2_LOAD(bcc) do { const int bc_ = (bcc), c_ = bc_ & 31, t0_ = bc_ * 64; \
        _Pragma("unroll") for (int i = 0; i < 7; ++i) { const int idx = tid + 512 * i; u32x4 v = {0u, 0u, 0u, 0u}; \
            if (idx < 67 * 48) { const int r = idx / 48, pc = idx - r * 48, seg = pc >> 4, c8 = (pc & 15) * 8, colg = seg * 2048 + h * 128 + c8; \
                if (r >= 3) v = *(const u32x4*)(DNQKV + (size_t)(t0_ + r - 3) * 6144 + colg); \
                else if (c_ > 0) v = *(const u32x4*)(HALO + ((size_t)(bc_ - 1) * 3 + r) * 6144 + colg); } \
            pre[i] = v; } \
        if (wid == 0) { pgb = GATES[(size_t)(t0_ + lane) * 64 + 16 + h]; pga = GATES[(size_t)(t0_ + lane) * 64 + 32 + h]; } } while (0)
    int bc = blockIdx.x >> 4;
    if (p.flags & 32) bc = 256;
    if (bc < 256) P2_LOAD(bc);
#pragma unroll 1
    for (; bc < 256; bc += bstep) {
        const int t0 = bc * 64; const int item = bc * 16 + h;
#pragma unroll
        for (int i = 0; i < 7; ++i) { const int idx = tid + 512 * i; if (idx < 67 * 48) { const int r = idx / 48, pc = idx - r * 48, seg = pc >> 4, c8 = (pc & 15) * 8; *(u32x4*)(sraw + r * 392 + seg * 128 + c8) = pre[i]; } }
        if (wid == 0) { const float beta = fast_sigmoid(pgb); const float xs = pga + dtb; const float g = alog * (fmaxf(xs, 0.f) + flog1pexp_negabs(xs));
            const float gam = dpp_incl_sum(g); sbeta[lane] = beta; sgam[lane] = gam; sbg[lane] = beta * fexp(gam);
            if (lane == 63) GE[item] = fexp(gam); }
        lds_bar();
        if (bc + bstep < 256) P2_LOAD(bc + bstep);
        if (!(p.flags & 2))
#pragma unroll 3
        for (int it = 0; it < 6; ++it) { const int idx = it * 512 + tid, cg16 = idx & 15, st = idx >> 4, which = st >> 6, t = st & 63, col = which * 128 + cg16 * 8;
            float y[8];
#pragma unroll
            for (int e = 0; e < 8; ++e) y[e] = 0.f;
#pragma unroll
            for (int j = 0; j < 4; ++j) { const u32x4 rv = *(const u32x4*)(sraw + (t + j) * 392 + col); float xv[8]; unpack8(rv, xv);
                const f32x4 w0 = *(const f32x4*)(scw + j * 384 + col), w1 = *(const f32x4*)(scw + j * 384 + col + 4);
#pragma unroll
                for (int e = 0; e < 4; ++e) { y[e] += w0[e] * xv[e]; y[4 + e] += w1[e] * xv[4 + e]; } }
            float ss = 0.f;
#pragma unroll
            for (int e = 0; e < 8; ++e) { y[e] = y[e] * fast_sigmoid(y[e]); ss += y[e] * y[e]; }
            ss = row16_sum(ss);
            const float scale = which == 2 ? 1.f : rsqrtf(ss + EPS) * (which == 0 ? 0.08838834764831845f : 1.f);
#pragma unroll
            for (int e = 0; e < 8; ++e) y[e] *= scale;
            bf16_t* dst = (which == 0 ? sqn : (which == 1 ? skn : svn)) + t * 136 + cg16 * 8;
            *(u32x4*)dst = pack8(y); }
        lds_bar();
        if (!(p.flags & 4)) { const int tr = wid >> 1, tcb = (wid & 1) * 2;
#pragma unroll
            for (int ti = 0; ti < 2; ++ti) { const int tc = tcb + ti; f32x4 akk = {0.f, 0.f, 0.f, 0.f}, aqk = {0.f, 0.f, 0.f, 0.f};
                if (tc <= tr) { mma16<4>(akk, skn, 136, tr * 16, skn, 136, tc * 16, lane); mma16<4>(aqk, sqn, 136, tr * 16, skn, 136, tc * 16, lane); }
                f32x4 av;
#pragma unroll
                for (int reg = 0; reg < 4; ++reg) { const int t = tr * 16 + q * 4 + reg, s = tc * 16 + cl; const float dec = (s <= t) ? fexp(sgam[t] - sgam[s]) : 0.f;
                    av[reg] = (s < t) ? sbeta[t] * akk[reg] * dec : 0.f;
                    QK[(size_t)(t0 + t) * 1024 + h * 64 + s] = f2bf(aqk[reg] * dec); }
                *(f32x4*)(sA + (tc * 16 + cl) * 80 + tr * 16 + q * 4) = av; } }
        { const float glast = sgam[63];
#pragma unroll
            for (int it = 0; it < 2; ++it) { const int rem = it * 512 + tid, t = rem >> 4, c8 = (rem & 15) * 8;
                const float sc = fexp(sgam[t]);
                float f[8]; unpack8(*(const u32x4*)(sqn + t * 136 + c8), f);
#pragma unroll
                for (int e = 0; e < 8; ++e) f[e] *= sc;
                *(u32x4*)(DNQKV + (size_t)(t0 + t) * 6144 + h * 128 + c8) = pack8(f); }
            { const int t = lane; const float sc = fexp(glast - sgam[t]);
#pragma unroll
                for (int i = 0; i < 2; ++i) { const int d8 = (wid * 2 + i) * 8; float f[8]; unpack8(*(const u32x4*)(skn + t * 136 + d8), f);
#pragma unroll
                    for (int e = 0; e < 8; ++e) { const int dk = d8 + e; DNQKV[(size_t)(t0 + (dk >> 1)) * 6144 + 2048 + h * 128 + (dk & 1) * 64 + t] = f2bf(f[e] * sc); } } } }
        lds_bar();
        if (wid < 4 && !(p.flags & 8)) { const int I = wid, j = lane & 15; float x[16];
            const f32x4 av = *(const f32x4*)(sA + (16 * I + (lane >> 2)) * 80 + 16 * I + (lane & 3) * 4);
#pragma unroll
            for (int i = 0; i < 16; ++i) x[i] = (i == j) ? 1.f : 0.f;
#pragma unroll
            for (int k = 0; k < 15; ++k) { const float xk = x[k];
#pragma unroll
                for (int i = k + 1; i < 16; ++i) { const float ae = av[i & 3]; const float a = __int_as_float(__builtin_amdgcn_readlane(__float_as_int(ae), k * 4 + (i >> 2))); x[i] -= a * xk; } }
            if (lane < 16) {
#pragma unroll
                for (int i = 0; i < 16; ++i) sT[I * 272 + i * 17 + j] = x[i]; } }
        if (wid >= 4) {
#pragma unroll
        for (int it = 0; it < 8; ++it) { const int idx = it * 256 + (tid - 256), which = idx >> 10, rem = idx & 1023, t = rem >> 4, c8 = (rem & 15) * 8;
            const float sc = which == 0 ? sbeta[t] : sbg[t];
            float f[8]; unpack8(*(const u32x4*)((which == 0 ? svn : skn) + t * 136 + c8), f);
            f32x4 o0, o1;
#pragma unroll
            for (int e = 0; e < 4; ++e) { o0[e] = f[e] * sc; o1[e] = f[4 + e] * sc; }
            float* d = sR + t * 272 + which * 128 + c8; *(f32x4*)d = o0; *(f32x4*)(d + 4) = o1; } }
        lds_bar();
        if (!(p.flags & 1)) {
            const int c0a = wid * 32 + cl, c0b = c0a + 16;
#pragma unroll
            for (int I = 0; I < 4; ++I) {
                if (I > 0) {
                    f32x4 acc0, acc1; float af[12], b0[12], b1[12];
#pragma unroll
                    for (int reg = 0; reg < 4; ++reg) { acc0[reg] = sR[(16 * I + q * 4 + reg) * 272 + c0a]; acc1[reg] = sR[(16 * I + q * 4 + reg) * 272 + c0b]; }
#pragma unroll
                    for (int kk = 0; kk < 4 * I; ++kk) { af[kk] = -sA[(4 * kk + q) * 80 + 16 * I + cl]; b0[kk] = sR[(4 * kk + q) * 272 + c0a]; b1[kk] = sR[(4 * kk + q) * 272 + c0b]; }
#pragma unroll
                    for (int kk = 0; kk < 4 * I; ++kk) { acc0 = __builtin_amdgcn_mfma_f32_16x16x4f32(af[kk], b0[kk], acc0, 0, 0, 0); acc1 = __builtin_amdgcn_mfma_f32_16x16x4f32(af[kk], b1[kk], acc1, 0, 0, 0); }
#pragma unroll
                    for (int reg = 0; reg < 4; ++reg) { sR[(16 * I + q * 4 + reg) * 272 + c0a] = acc0[reg]; sR[(16 * I + q * 4 + reg) * 272 + c0b] = acc1[reg]; }
                }
                { float ta[4], d0[4], d1[4]; f32x4 x0 = {0.f, 0.f, 0.f, 0.f}, x1 = {0.f, 0.f, 0.f, 0.f};
#pragma unroll
                    for (int kk = 0; kk < 4; ++kk) { ta[kk] = sT[I * 272 + cl * 17 + 4 * kk + q]; d0[kk] = sR[(16 * I + 4 * kk + q) * 272 + c0a]; d1[kk] = sR[(16 * I + 4 * kk + q) * 272 + c0b]; }
#pragma unroll
                    for (int kk = 0; kk < 4; ++kk) { x0 = __builtin_amdgcn_mfma_f32_16x16x4f32(ta[kk], d0[kk], x0, 0, 0, 0); x1 = __builtin_amdgcn_mfma_f32_16x16x4f32(ta[kk], d1[kk], x1, 0, 0, 0); }
#pragma unroll
                    for (int reg = 0; reg < 4; ++reg) { sR[(16 * I + q * 4 + reg) * 272 + c0a] = x0[reg]; sR[(16 * I + q * 4 + reg) * 272 + c0b] = x1[reg]; }
                }
            }
        }
        lds_bar();
#pragma unroll
        for (int it = 0; it < 4; ++it) { const int idx = it * 512 + tid, which = idx >> 10, rem = idx & 1023, t = rem >> 4, c8 = (rem & 15) * 8;
            const float* d = sR + t * 272 + which * 128 + c8; const f32x4 o0 = *(const f32x4*)d, o1 = *(const f32x4*)(d + 4);
            u32x4 w; w.x = pk(o0[0], o0[1]); w.y = pk(o0[2], o0[3]); w.z = pk(o1[0], o1[1]); w.w = pk(o1[2], o1[3]);
            if (which == 0) *(u32x4*)(DNQKV + (size_t)(t0 + t) * 6144 + 4096 + h * 128 + c8) = w;
            else *(u32x4*)(WK + (size_t)(t0 + t) * 2048 + h * 128 + c8) = w; }
        lds_bar();
    }
#undef P2_LOAD
}

DI void scan_dn(const Params& p, unsigned char* lds, int item) {
    const int tid = threadIdx.x, lane = tid & 63, wid = tid >> 6, q = lane >> 4, cl = lane & 15;
    const int b = item >> 4, h = item & 15;
    bf16_t* swk = (bf16_t*)lds;
    bf16_t* sqd = swk + 64 * 136;
    bf16_t* swv = sqd + 64 * 136;
    bf16_t* sqk = swv + 64 * 136;
    bf16_t* skeT = sqk + 64 * 72;
    bf16_t* suT = skeT + 128 * 72;
    bf16_t* sSt = suT + 128 * 72;
    bf16_t* ssz = sSt + 128 * 136;
    float* sssq = (float*)(ssz + 64 * 136);
    bf16_t* SDZ = (bf16_t*)(p.ws + OFF_SDZ);
    bf16_t* DNQKV = (bf16_t*)(p.ws + OFF_DNQKV); const bf16_t* WK = (const bf16_t*)(p.ws + OFF_WK); const bf16_t* QK = (const bf16_t*)(p.ws + OFF_QK);
    const float* GE = (const float*)(p.ws + OFF_GE);
    for (int i = tid; i < 128 * 136 / 2; i += 512) ((unsigned*)sSt)[i] = 0u;
    f32x4 accS[8];
#pragma unroll
    for (int i = 0; i < 8; ++i) accS[i] = (f32x4){0.f, 0.f, 0.f, 0.f};
    bf16_t* oout = SDZ + (size_t)b * 2048 * 2048 + h * 128;
    u32x4 rwk[2], rqd[2], rke[2], rwv[2], rsz[2], rqk; float ge;
    f32x4 nw[4];
#pragma unroll
    for (int j = 0; j < 4; ++j) nw[j] = *(const f32x4*)(p.dn_norm_w + ((wid >> 2) * 4 + j) * 16 + q * 4);
#define DN_LOAD(cc) do { const size_t tb = (size_t)b * 2048 + (size_t)(cc) * 64; \
        _Pragma("unroll") for (int i = 0; i < 2; ++i) { const int piece = tid + 512 * i, t = piece >> 4, c8 = (piece & 15) * 8; const size_t ro = (tb + t) * 6144 + h * 128 + c8; \
            rwk[i] = *(const u32x4*)(WK + (tb + t) * 2048 + h * 128 + c8); rqd[i] = *(const u32x4*)(DNQKV + ro); rke[i] = *(const u32x4*)(DNQKV + ro + 2048); rwv[i] = *(const u32x4*)(DNQKV + ro + 4096); rsz[i] = *(const u32x4*)(SDZ + (tb + t) * 2048 + h * 128 + c8); } \
        rqk = *(const u32x4*)(QK + (tb + (tid >> 3)) * 1024 + h * 64 + (tid & 7) * 8); \
        ge = GE[((size_t)(b * 32 + (cc))) * 16 + h]; } while (0)
    DN_LOAD(0);
    lds_bar();
#pragma unroll 1
    for (int c = 0; c < 32; ++c) {
        const size_t t0 = (size_t)b * 2048 + (size_t)c * 64;
#pragma unroll
        for (int i = 0; i < 2; ++i) { const int piece = tid + 512 * i, t = piece >> 4, c8 = (piece & 15) * 8;
            *(u32x4*)(swk + t * 136 + c8) = rwk[i]; *(u32x4*)(sqd + t * 136 + c8) = rqd[i]; *(u32x4*)(swv + t * 136 + c8) = rwv[i]; *(u32x4*)(ssz + t * 136 + c8) = rsz[i];
            *(u32x4*)(skeT + (2 * t + (c8 >> 6)) * 72 + (c8 & 63)) = rke[i]; }
        *(u32x4*)(sqk + (tid >> 3) * 72 + (tid & 7) * 8) = rqk;
        const float gec = ge;
        if (c + 1 < 32) DN_LOAD(c + 1);
        lds_bar();
        const int tr = wid & 3, hb = (wid >> 2) * 4;
        bf16x8 afk[4]; lda16<4>(afk, swk, 136, tr * 16, lane);
#pragma unroll
        for (int j = 0; j < 4; ++j) { const int nt = hb + j; f32x4 a = {0.f, 0.f, 0.f, 0.f};
            mma16r<4>(a, afk, sSt, 136, nt * 16, lane);
            const int dv = nt * 16 + cl, tq = tr * 16 + q * 4;
            const float u0 = bf2f(swv[(tq + 0) * 136 + dv]) - a[0], u1 = bf2f(swv[(tq + 1) * 136 + dv]) - a[1], u2 = bf2f(swv[(tq + 2) * 136 + dv]) - a[2], u3 = bf2f(swv[(tq + 3) * 136 + dv]) - a[3];
            u32x2 w; w.x = pk(u0, u1); w.y = pk(u2, u3); *(u32x2*)(suT + dv * 72 + tq) = w; }
        lds_bar();
        bf16x8 afq[4], afs[2]; lda16<4>(afq, sqd, 136, tr * 16, lane); lda16<2>(afs, sqk, 72, tr * 16, lane);
        f32x4 ao[4]; float psq = 0.f;
        const int to = tr * 16 + cl;
#pragma unroll
        for (int j = 0; j < 4; ++j) { const int nt = hb + j; ao[j] = (f32x4){0.f, 0.f, 0.f, 0.f};
            mma16rT<4>(ao[j], afq, sSt, 136, nt * 16, lane);
            mma16rT<2>(ao[j], afs, suT, 72, nt * 16, lane);
            psq += ao[j][0] * ao[j][0] + ao[j][1] * ao[j][1] + ao[j][2] * ao[j][2] + ao[j][3] * ao[j][3];
            const u32x2 zz = *(const u32x2*)(ssz + to * 136 + nt * 16 + q * 4);
            ao[j][0] *= nw[j][0] * bflo(zz.x); ao[j][1] *= nw[j][1] * bfhi(zz.x); ao[j][2] *= nw[j][2] * bflo(zz.y); ao[j][3] *= nw[j][3] * bfhi(zz.y); }
        psq += __shfl_xor(psq, 16); psq += __shfl_xor(psq, 32);
        if (q == 0) sssq[(wid >> 2) * 64 + to] = psq;
        bf16x8 afe[2]; lda16<2>(afe, skeT, 72, wid * 16, lane);
#pragma unroll
        for (int nt = 0; nt < 8; ++nt) { accS[nt] *= gec; mma16r<2>(accS[nt], afe, suT, 72, nt * 16, lane); if (nt & 1) asm volatile("" ::: "memory"); }
        lds_bar();
#pragma unroll
        for (int nt = 0; nt < 8; ++nt) { const int dv = nt * 16 + cl, dk0 = wid * 16 + q * 4; u32x2 w; w.x = pk(accS[nt][0], accS[nt][1]); w.y = pk(accS[nt][2], accS[nt][3]); *(u32x2*)(sSt + dv * 136 + dk0) = w; }
        { const float rs = rsqrtf((sssq[to] + sssq[64 + to]) * (1.f / 128.f) + EPS);
#pragma unroll
            for (int j = 0; j < 4; ++j) { u32x2 w; w.x = pk(ao[j][0] * rs, ao[j][1] * rs); w.y = pk(ao[j][2] * rs, ao[j][3] * rs);
                *(u32x2*)(oout + (unsigned)((c * 64 + to) * 2048 + (hb + j) * 16 + q * 4)) = w; } }
    }
#undef DN_LOAD
    lds_bar();
}

DI void scan_ml(const Params& p, unsigned char* lds, int item) {
    const int tid = threadIdx.x, lane = tid & 63, wid = tid >> 6, q = lane >> 4, cl = lane & 15;
    const int b = item >> 4, h = (item >> 1) & 7, sl = item & 1, vcol = h * 256 + sl * 128;
    bf16_t* sq = (bf16_t*)lds;
    bf16_t* sk = sq + 64 * 136;
    bf16_t* sCt = sk + 64 * 136;
    bf16_t* skwT = sCt + 144 * 136;
    bf16_t* sVt = skwT + 128 * 72;
    bf16_t* sP = sVt + 144 * 72;
    float* sf = (float*)(sP + 64 * 72);
    float *s_bcum = sf, *s_a = sf + 64, *s_mt = sf + 128, *s_iw = sf + 192, *s_emt = sf + 256, *s_ew = sf + 320, *s_sc = sf + 384;
    bf16_t* sv = (bf16_t*)(lds + 124416);
    const bf16_t* MLQ = (const bf16_t*)(p.ws + OFF_MLQ); const bf16_t* MLK = (const bf16_t*)(p.ws + OFF_MLK); bf16_t* MLV = (bf16_t*)(p.ws + OFF_MLV);
    const float* GATES = (const float*)(p.ws + OFF_GATES);
    for (int i = tid; i < 144 * 136 / 2; i += 512) ((unsigned*)sCt)[i] = 0u;
    for (int i = tid; i < 16 * 72; i += 512) sVt[128 * 72 + i] = (i < 72) ? (bf16_t)0x3F80u : (bf16_t)0u;
    f32x4 accC[9];
#pragma unroll
    for (int i = 0; i < 9; ++i) accC[i] = (f32x4){0.f, 0.f, 0.f, 0.f};
    const float ibias = p.ml_i_bias[h], fbias = p.ml_f_bias[h];
    bf16_t* hout = MLV + (size_t)b * 2048 * 2048 + vcol;
    float m_run = 0.f;
    u32x4 rq[2], rk[2], rv[2]; float gi = 0.f, gf = 0.f;
#define ML_LOAD(cc) do { const size_t tb = (size_t)b * 2048 + (size_t)(cc) * 64; \
        _Pragma("unroll") for (int i = 0; i < 2; ++i) { const int piece = tid + 512 * i, t = piece >> 4, c8 = (piece & 15) * 8; \
            rq[i] = *(const u32x4*)(MLQ + (tb + t) * 1024 + h * 128 + c8); rk[i] = *(const u32x4*)(MLK + (tb + t) * 1024 + h * 128 + c8); rv[i] = *(const u32x4*)(MLV + (tb + t) * 2048 + vcol + c8); } \
        if (wid == 0) { gi = GATES[(tb + lane) * 64 + h]; gf = GATES[(tb + lane) * 64 + 8 + h]; } } while (0)
    ML_LOAD(0);
    lds_bar();
#pragma unroll 1
    for (int c = 0; c < 32; ++c) {
        const size_t t0 = (size_t)b * 2048 + (size_t)c * 64;
#pragma unroll
        for (int i = 0; i < 2; ++i) { const int piece = tid + 512 * i, t = piece >> 4, c8 = (piece & 15) * 8;
            *(u32x4*)(sq + t * 136 + c8) = rq[i]; *(u32x4*)(sk + t * 136 + c8) = rk[i]; *(u32x4*)(sv + t * 136 + c8) = rv[i]; }
        if (wid == 0) {
            const float ipre = fsoftcap(gi + ibias); const float fc = fsoftcap(gf + fbias); const float lf = fminf(fc, 0.f) - flog1pexp_negabs(fc);
            const float bcum = dpp_incl_sum(lf); const float a = ipre - bcum; const float pm = dpp_incl_max(a);
            const float bl = __int_as_float(__builtin_amdgcn_readlane(__float_as_int(bcum), 63)), pml = __int_as_float(__builtin_amdgcn_readlane(__float_as_int(pm), 63));
            const float il = bcum + m_run, mt = fmaxf(il, bcum + pm);
            const float mnew = fmaxf(bl + m_run, bl + pml);
            s_bcum[lane] = bcum; s_a[lane] = a; s_mt[lane] = mt; s_iw[lane] = fexp(il - mt); s_emt[lane] = fexp(-mt); s_ew[lane] = fexp(bl + a - mnew);
            if (lane == 0) s_sc[0] = fexp(bl + m_run - mnew);
            m_run = mnew;
        }
        if (c + 1 < 32) ML_LOAD(c + 1);
        lds_bar();
#pragma unroll
        for (int i = 0; i < 2; ++i) { const int t = lane, d8 = (wid * 2 + i) * 8; float f[8]; unpack8(*(const u32x4*)(sk + t * 136 + d8), f); const float ew = s_ew[t];
#pragma unroll
            for (int e = 0; e < 8; ++e) skwT[(d8 + e) * 72 + t] = f2bf(f[e] * ew); }
        asm volatile("" ::: "memory");
#pragma unroll
        for (int i = 0; i < 2; ++i) { const int t = lane, d8 = (wid * 2 + i) * 8; const u32x4 vv = *(const u32x4*)(sv + t * 136 + d8);
#pragma unroll
            for (int e = 0; e < 8; ++e) sVt[(d8 + e) * 72 + t] = (bf16_t)((vv[e >> 1] >> ((e & 1) * 16)) & 0xffffu); }
        asm volatile("" ::: "memory");
        { const int tr = wid >> 1, tcb = (wid & 1) * 2;
            bf16x8 afq[4]; lda16<4>(afq, sq, 136, tr * 16, lane);
#pragma unroll
            for (int ti = 0; ti < 2; ++ti) { const int tc = tcb + ti; f32x4 a = {0.f, 0.f, 0.f, 0.f};
                if (tc <= tr) mma16r<4>(a, afq, sk, 136, tc * 16, lane);
#pragma unroll
                for (int reg = 0; reg < 4; ++reg) { const int t = tr * 16 + q * 4 + reg, s = tc * 16 + cl;
                    const float w = (s <= t) ? fexp(s_bcum[t] + s_a[s] - s_mt[t]) * a[reg] : 0.f;
                    sP[t * 72 + s] = f2bf(w); } } }
        lds_bar();
        { const int tr = wid & 3, hb = (wid >> 2) * 4, tq = tr * 16 + q * 4;
            f32x4 an[5];
#pragma unroll
            for (int j = 0; j < 5; ++j) { const int nt = j < 4 ? hb + j : 8; an[j] = (f32x4){0.f, 0.f, 0.f, 0.f}; mma16<4>(an[j], sq, 136, tr * 16, sCt, 136, nt * 16, lane); asm volatile("" ::: "memory"); }
            bf16x8 afp[2]; lda16<2>(afp, sP, 72, tr * 16, lane);
            f32x4 iw; iw[0] = s_iw[tq]; iw[1] = s_iw[tq + 1]; iw[2] = s_iw[tq + 2]; iw[3] = s_iw[tq + 3];
#pragma unroll
            for (int j = 0; j < 5; ++j) { const int nt = j < 4 ? hb + j : 8; an[j] *= iw; mma16r<2>(an[j], afp, sVt, 72, nt * 16, lane); }
            float rden[4];
#pragma unroll
            for (int reg = 0; reg < 4; ++reg) { const float den = __shfl(an[4][reg], lane & 48); rden[reg] = __builtin_amdgcn_rcpf(fmaxf(fabsf(den), s_emt[tq + reg])); }
#pragma unroll
            for (int j = 0; j < 4; ++j) { const int dv = (hb + j) * 16 + cl;
#pragma unroll
                for (int reg = 0; reg < 4; ++reg) hout[(unsigned)((c * 64 + tq + reg) * 2048 + dv)] = f2bf(an[j][reg] * rden[reg]); }
            const float decay = s_sc[0];
            bf16x8 afw[2]; lda16<2>(afw, skwT, 72, wid * 16, lane);
#pragma unroll
            for (int nt = 0; nt < 9; ++nt) { accC[nt] *= decay; mma16r<2>(accC[nt], afw, sVt, 72, nt * 16, lane); if (nt & 1) asm volatile("" ::: "memory"); }
        }
        lds_bar();
#pragma unroll
        for (int nt = 0; nt < 9; ++nt) { const int dv = nt * 16 + cl, dk0 = wid * 16 + q * 4; u32x2 w; w.x = pk(accC[nt][0], accC[nt][1]); w.y = pk(accC[nt][2], accC[nt][3]); *(u32x2*)(sCt + dv * 136 + dk0) = w; }
    }
#undef ML_LOAD
    lds_bar();
}

DI void p4_normgate(const Params& p) {
    const int tid = threadIdx.x, lane = tid & 63, wid = tid >> 6;
    bf16_t* MLV = (bf16_t*)(p.ws + OFF_MLV); const bf16_t* OZ = (const bf16_t*)(p.ws + OFF_OZ);
    const bf16_t* DNQKV = (const bf16_t*)(p.ws + OFF_DNQKV); const bf16_t* SDZ = (const bf16_t*)(p.ws + OFF_SDZ); bf16_t* AB = (bf16_t*)(p.ws + OFF_MLQ);
    for (int tok = blockIdx.x * 8 + wid; tok < T_TOK; tok += gridDim.x * 8) {
#pragma unroll
        for (int it = 0; it < 4; ++it) { const int c0 = it * 512 + lane * 8; float hv[8], gv[8];
            unpack8(*(const u32x4*)(MLV + (size_t)tok * 2048 + c0), hv); unpack8(*(const u32x4*)(OZ + (size_t)tok * 2048 + c0), gv);
            float ss = 0.f;
#pragma unroll
            for (int e = 0; e < 8; ++e) ss += hv[e] * hv[e];
            ss = row16_sum(ss); ss += __shfl_xor(ss, 16);
            const float rs = rsqrtf(ss * (1.f / 256.f) + EPS);
            const float4 w0 = *(const float4*)(p.ml_norm_w + c0), w1 = *(const float4*)(p.ml_norm_w + c0 + 4);
            const float w[8] = {w0.x, w0.y, w0.z, w0.w, w1.x, w1.y, w1.z, w1.w};
#pragma unroll
            for (int e = 0; e < 8; ++e) hv[e] = hv[e] * rs * w[e] * gv[e];
            *(u32x4*)(MLV + (size_t)tok * 2048 + c0) = pack8(hv); }
    }
}

DI void p6_final(const Params& p) {
    const int tid = threadIdx.x, lane = tid & 63, wid = tid >> 6;
    const float* rowss = (const float*)(p.ws + OFF_ROWSS);
    for (int tok = blockIdx.x * 8 + wid; tok < T_TOK; tok += gridDim.x * 8) {
        const float rs = rsqrtf(rowss[tok] * (1.f / 2048.f) + EPS);
        float4* o = (float4*)(p.out + (size_t)tok * 2048);
#pragma unroll
        for (int i = 0; i < 8; ++i) { float4 v = o[i * 64 + lane]; const float4 w = ((const float4*)p.final_norm_w)[i * 64 + lane];
            v.x *= rs * w.x; v.y *= rs * w.y; v.z *= rs * w.z; v.w *= rs * w.w; o[i * 64 + lane] = v; }
    }
}


#ifdef DBG
DI void p7_debug(const Params& p) {
    const bf16_t* MLV = (const bf16_t*)(p.ws + OFF_MLV); const bf16_t* MLQ = (const bf16_t*)(p.ws + OFF_MLQ); const bf16_t* MLK = (const bf16_t*)(p.ws + OFF_MLK);
    const bf16_t* OZ = (const bf16_t*)(p.ws + OFF_OZ); const bf16_t* DNQKV = (const bf16_t*)(p.ws + OFF_DNQKV); const bf16_t* SDZ = (const bf16_t*)(p.ws + OFF_SDZ);
    const float* GATES = (const float*)(p.ws + OFF_GATES); const bf16_t* WK = (const bf16_t*)(p.ws + OFF_WK); const bf16_t* QK = (const bf16_t*)(p.ws + OFF_QK);
    const float* GE = (const float*)(p.ws + OFF_GE); const bf16_t* AB = (const bf16_t*)(p.ws + OFF_MLQ);
    for (size_t i = (size_t)blockIdx.x * 512 + threadIdx.x; i < (size_t)T_TOK * 2048; i += (size_t)gridDim.x * 512) {
        const size_t t = i >> 11; const int c = (int)(i & 2047); float v = 0.f;
#if DBG == 1
        const unsigned pr = ((const unsigned*)p.out)[i];
        v = bf2f(MLV[t * 2048 + c]) + bf2f(OZ[t * 2048 + c]) + bf2f(SDZ[t * 2048 + c]) + bf2f(DNQKV[t * 6144 + c]) + bf2f(DNQKV[t * 6144 + 2048 + c]) + bf2f(DNQKV[t * 6144 + 4096 + c])
          + bf2f(MLQ[t * 1024 + (c & 1023)]) + bf2f(MLK[t * 1024 + (c & 1023)]) + GATES[t * 64 + (c & 63)] + bflo(pr) + bfhi(pr);
#elif DBG == 2
        v = bf2f(DNQKV[t * 6144 + c]) + bf2f(DNQKV[t * 6144 + 2048 + c]) + bf2f(DNQKV[t * 6144 + 4096 + c]) + bf2f(WK[t * 2048 + c]) + bf2f(QK[t * 1024 + (c & 1023)]) + GE[(t >> 6) * 16 + (c & 15)];
#elif DBG == 3
        v = bf2f(MLV[t * 2048 + c]) + bf2f(DNQKV[t * 6144 + 4096 + c]);
#elif DBG == 4
        v = bf2f(MLV[t * 2048 + c]) + bf2f(AB[t * 2048 + c]);
#elif DBG == 5
        v = bf2f(MLV[t * 2048 + c]);
#elif DBG == 6
        v = bf2f(DNQKV[t * 6144 + 4096 + c]);
#endif
        p.out[i] = v;
    }
}
#endif
__global__ void __launch_bounds__(512) hybrid_fwd(Params p) {
    extern __shared__ __attribute__((aligned(16))) unsigned char lds[];
    cg::grid_group grid = cg::this_grid();
    const int lo = p.ph_lo, hi = p.ph_hi;
    volatile LAS unsigned* xst = (volatile LAS unsigned*)((LAS unsigned char*)lds + (LDS_BYTES - 16));
    if (threadIdx.x < 4) xst[threadIdx.x] = 0u;
    __syncthreads();
    XcdBarrier xbar; xbar.bar = (unsigned*)(p.ws + OFF_BAR); xbar.x = 0; xbar.st = xst;
    if (hi - lo > 1) xbar = xcd_barrier_post((unsigned*)(p.ws + OFF_BAR), xst);
#ifndef PH_MASK
#define PH_MASK 127
#endif
#define IN(k) (((PH_MASK >> (k)) & 1) && lo <= (k) && (k) < hi)
#define SEAM(k) do { if (IN(k) && IN((k) + 1)) { if (p.flags == 0x40000000) grid.sync(); else xcd_barrier(xbar); } } while (0)
    if (IN(0)) p0_prologue(p, lds);
    SEAM(0);
    if (IN(1)) {
        pg8::Gemm g{(const pg8::bf16_t*)(p.ws + OFF_U), (const pg8::bf16_t*)(p.ws + OFF_WT), T_TOK, NPAD, 2048};
        SuperTileOrder S{(int)gridDim.x, (int)blockIdx.x};
        EpiProj E{p.ws, (unsigned*)p.out, p.flags};
        pg8::gemm_phase<EpiProj, SuperTileOrder>((PG8_LAS unsigned char*)lds, g, S, E, nullptr);
    }
    SEAM(1);
    if (IN(2)) p2_dnprep(p, lds);
    SEAM(2);
    if (IN(3)) {
#ifndef NO_DN
        if (!(p.flags & 64)) for (int item = blockIdx.x; item < 256; item += gridDim.x) if (item < 128) scan_dn(p, lds, item);
#endif
#ifndef NO_ML
        if (!(p.flags & 128)) for (int item = blockIdx.x; item < 256; item += gridDim.x) if (item >= 128) scan_ml(p, lds, item - 128);
        { const int nml = gridDim.x > 128 ? (int)gridDim.x - 128 : (int)gridDim.x, fml = gridDim.x > 128 ? (int)blockIdx.x - 128 : (int)blockIdx.x;
          if (fml >= 0) p0_transpose(p, lds, (NPAD / 256) * 32, (NPAD / 256) * 32 + 2 * 8 * 32, fml, nml); }
#endif
    }
    SEAM(3);
    if (IN(4)) p4_normgate(p);
    SEAM(4);
    if (IN(5)) {
        pg8::Gemm g{(const pg8::bf16_t*)(p.ws + OFF_MLV), (const pg8::bf16_t*)(p.ws + OFF_WOT), 2 * T_TOK, 4096, 2048};
        OutOrder S; S.so.init(T_TOK, 2048, (int)gridDim.x, (int)blockIdx.x);
        EpiOut E{p.x, p.out, (float*)(p.ws + OFF_ROWSS)};
        pg8::gemm_phase<EpiOut, OutOrder>((PG8_LAS unsigned char*)lds, g, S, E, nullptr);
    }
    SEAM(5);
    if (IN(6)) p6_final(p);
#ifdef EXTRA_SYNCS
    if (hi == 7) { for (int i = 0; i < EXTRA_SYNCS; ++i) grid.sync(); }
#endif
#ifdef DBG
    if (p.ph_lo == 7) p7_debug(p);
#endif
#undef IN
#undef SEAM
}

#ifndef N_LAUNCHES
#define N_LAUNCHES 7
#endif
extern "C" void kernel_launch(void* const* d_in, const int* in_sizes, int n_in, void* d_out, int out_size, void* d_ws, size_t ws_size, hipStream_t stream) {
    static int grid = 0;
    if (grid == 0) {
        if (n_in != 12 || out_size != T_TOK * DM || ws_size < WS_END) { fprintf(stderr, "kernel_launch: bad shapes / workspace (%zu < %zu)\n", ws_size, (size_t)WS_END); grid = -1; return; }
        int dev = 0, cus = 0, per_cu = 0;
        hipGetDevice(&dev); hipDeviceGetAttribute(&cus, hipDeviceAttributeMultiprocessorCount, dev);
        if (hipFuncSetAttribute((const void*)hybrid_fwd, hipFuncAttributeMaxDynamicSharedMemorySize, LDS_BYTES) != hipSuccess) { fprintf(stderr, "hipFuncSetAttribute failed\n"); grid = -1; return; }
        if (hipOccupancyMaxActiveBlocksPerMultiprocessor(&per_cu, (const void*)hybrid_fwd, 512, LDS_BYTES) != hipSuccess || per_cu < 1) { fprintf(stderr, "occupancy query: %d\n", per_cu); per_cu = 1; }
        (void)hipGetLastError();
        grid = cus * 1;
    }
    if (grid < 0) return;
    Params p{};
    p.x = (const float*)d_in[0]; p.norm_w = (const float*)d_in[1]; p.w_in = (const float*)d_in[2]; p.ml_i_bias = (const float*)d_in[3]; p.ml_f_bias = (const float*)d_in[4];
    p.ml_norm_w = (const float*)d_in[5]; p.dn_conv_w = (const float*)d_in[6]; p.dn_a_log = (const float*)d_in[7]; p.dn_dt_bias = (const float*)d_in[8]; p.dn_norm_w = (const float*)d_in[9];
    p.w_out = (const float*)d_in[10]; p.final_norm_w = (const float*)d_in[11]; p.out = (float*)d_out; p.ws = (unsigned char*)d_ws;
#if N_LAUNCHES == 1
    (void)hipMemsetAsync((unsigned char*)d_ws + OFF_BAR, 0, (size_t)XCD_BAR_WORDS * 4, stream);
    void* args[] = {&p};
#ifdef REP_HI
    p.ph_lo = REP_LO; p.ph_hi = REP_HI + 1;
#ifdef REP_FLAGS
    p.flags = REP_FLAGS;
#endif
    (void)hipLaunchCooperativeKernel((const void*)hybrid_fwd, dim3(grid), dim3(512), args, LDS_BYTES, stream);
#endif
#ifdef REP_HI
    (void)hipMemsetAsync((unsigned char*)d_ws + OFF_BAR, 0, (size_t)XCD_BAR_WORDS * 4, stream);
#endif
    p.ph_lo = 0; p.ph_hi = 7; p.flags = 0;
    hipError_t e = hipLaunchCooperativeKernel((const void*)hybrid_fwd, dim3(grid), dim3(512), args, LDS_BYTES, stream);
    if (e != hipSuccess) fprintf(stderr, "cooperative launch failed: %s (grid %d)\n", hipGetErrorString(e), grid);
#else
#ifdef DBG
    const int nph = (DBG == 1) ? 2 : (DBG == 2) ? 3 : (DBG == 4) ? 5 : 4;
    for (int ph = 0; ph < nph; ++ph) { p.ph_lo = ph; p.ph_hi = ph + 1; hipLaunchKernelGGL(hybrid_fwd, dim3(grid), dim3(512), LDS_BYTES, stream, p); }
    p.ph_lo = 7; p.ph_hi = 8; hipLaunchKernelGGL(hybrid_fwd, dim3(grid), dim3(512), LDS_BYTES, stream, p);
#else
    for (int ph = 0; ph < 7; ++ph) { p.ph_lo = ph; p.ph_hi = ph + 1; hipLaunchKernelGGL(hybrid_fwd, dim3(grid), dim3(512), LDS_BYTES, stream, p); }
#endif
#endif
}
```
